# Optimizing an MI355X kernel written in HIP

```python
import math
import jax, jax.numpy as jnp
from jax import lax
import numpy as np

D_MODEL = 1024
BATCH = 8
SEQ = 4096
DEPTH = 2

N_A = DEPTH // 2
N_B = DEPTH - N_A

EXPAND = 2
D_INNER = EXPAND * D_MODEL
SSM_HEAD_DIM = 64
SSM_HEADS = D_INNER // SSM_HEAD_DIM
N_GROUPS = 4
HEADS_PER_GROUP = SSM_HEADS // N_GROUPS
D_STATE = 128
CONV_K = 4
CONV_DIM = D_INNER + 2 * N_GROUPS * D_STATE
IN_PROJ_DIM = 2 * D_INNER + 2 * N_GROUPS * D_STATE + SSM_HEADS
CHUNK = 128
DT_MIN = 0.001
DT_MAX = 0.1

SB_HEAD_DIM = 64
SB_HEADS = D_MODEL // SB_HEAD_DIM
SB_WIDTH = SB_HEADS * SB_HEAD_DIM
SB_BLOCK = 128

PLE_DIM = 256

NORM_EPS = 1e-6

kernel_name = "yoco_mamba2_stickbreaking_hybrid"


def rms(x):
    xf = x.astype(jnp.float32)
    return (xf * lax.rsqrt(jnp.mean(xf * xf, axis=-1, keepdims=True) + NORM_EPS)).astype(x.dtype)


def rmsnorm(x, g):
    return rms(x) * g.astype(x.dtype)


def causal_depthwise_conv(u, w, b):
    k = w.shape[0]
    s = u.shape[1]
    up = jnp.pad(u, ((0, 0), (k - 1, 0), (0, 0)))
    out = b
    for j in range(k):
        out = out + w[j] * up[:, j:j + s]
    return out


def ssd_chunked_scan(xs, dt, A, Bm, Cm):
    bsz, s, _, _ = xs.shape
    nc = s // CHUNK
    G, HG, P, N, L = N_GROUPS, HEADS_PER_GROUP, SSM_HEAD_DIM, D_STATE, CHUNK
    xc = xs.astype(jnp.float32).reshape(bsz, nc, L, G, HG, P).transpose(1, 0, 2, 3, 4, 5)
    dtc = dt.reshape(bsz, nc, L, G, HG).transpose(1, 0, 2, 3, 4)
    Bc = Bm.astype(jnp.float32).reshape(bsz, nc, L, G, N).transpose(1, 0, 2, 3, 4)
    Cc = Cm.astype(jnp.float32).reshape(bsz, nc, L, G, N).transpose(1, 0, 2, 3, 4)
    Ag = A.reshape(G, HG)
    causal = jnp.tril(jnp.ones((L, L), dtype=bool))

    def step(state, inp):
        x_k, dt_k, B_k, C_k = inp
        acum = jnp.cumsum(dt_k * Ag, axis=1)
        seg = acum[:, :, None] - acum[:, None, :]
        decay = jnp.exp(jnp.where(causal[None, :, :, None, None], seg, -jnp.inf))
        xdt = x_k * dt_k[..., None]
        cb = jnp.einsum('blgn,bsgn->blsg', C_k, B_k)
        y_intra = jnp.einsum('blsgh,bsghp->blghp', cb[..., None] * decay, xdt)
        y_inter = jnp.einsum('blgn,bghpn->blghp', C_k, state) * jnp.exp(acum)[..., None]
        to_end = jnp.exp(acum[:, -1:] - acum)
        new_state = state * jnp.exp(acum[:, -1])[..., None, None] + jnp.einsum(
            'bsgn,bsghp->bghpn', B_k, xdt * to_end[..., None])
        return new_state, y_intra + y_inter

    state0 = jnp.zeros((bsz, G, HG, P, N), jnp.float32)
    _, y = lax.scan(step, state0, (xc, dtc, Bc, Cc))
    y = y.transpose(1, 0, 2, 3, 4, 5).reshape(bsz, s, SSM_HEADS, P)
    return y.astype(xs.dtype)


def mamba2_mixer(h, norm_g, w_in, conv_w, conv_b, dt_bias, A_log, d_skip, y_g, w_out):
    bsz, s, _ = h.shape
    u = rmsnorm(h, norm_g)
    zxbcdt = u @ w_in
    z = zxbcdt[..., :D_INNER]
    xbc = zxbcdt[..., D_INNER:D_INNER + CONV_DIM]
    dt = zxbcdt[..., D_INNER + CONV_DIM:]
    xbc = jax.nn.silu(causal_depthwise_conv(xbc, conv_w, conv_b))
    xs = xbc[..., :D_INNER].reshape(bsz, s, SSM_HEADS, SSM_HEAD_DIM)
    Bm = xbc[..., D_INNER:D_INNER + N_GROUPS * D_STATE].reshape(bsz, s, N_GROUPS, D_STATE)
    Cm = xbc[..., D_INNER + N_GROUPS * D_STATE:].reshape(bsz, s, N_GROUPS, D_STATE)
    dt = jax.nn.softplus(dt.astype(jnp.float32) + dt_bias.astype(jnp.float32))
    A = -jnp.exp(A_log.astype(jnp.float32))
    y = ssd_chunked_scan(xs, dt, A, Bm, Cm)
    y = y + d_skip.astype(y.dtype)[:, None] * xs
    y = y.reshape(bsz, s, D_INNER) * jax.nn.silu(z)
    y = rms(y.reshape(bsz, s, N_GROUPS, D_INNER // N_GROUPS)).reshape(bsz, s, D_INNER) * y_g
    return y @ w_out


def shared_kv(h, norm_g, w_kv, k_g):
    bsz, s, _ = h.shape
    kv = rmsnorm(h, norm_g) @ w_kv
    k = rmsnorm(kv[..., :SB_WIDTH].reshape(bsz, s, SB_HEADS, SB_HEAD_DIM), k_g)
    v = kv[..., SB_WIDTH:].reshape(bsz, s, SB_HEADS, SB_HEAD_DIM)
    return k.transpose(0, 2, 1, 3), v.transpose(0, 2, 1, 3)


def stick_breaking_mixer(h, k, v, norm_g, w_in, q_g, w_out):
    bsz, s, _ = h.shape
    qg = rmsnorm(h, norm_g) @ w_in
    gate = qg[..., SB_WIDTH:]
    q = rmsnorm(qg[..., :SB_WIDTH].reshape(bsz, s, SB_HEADS, SB_HEAD_DIM), q_g)
    q = (q * (1.0 / math.sqrt(SB_HEAD_DIM))).transpose(0, 2, 1, 3)
    outs = []
    for blk in range(s // SB_BLOCK):
        q0 = blk * SB_BLOCK
        kend = q0 + SB_BLOCK
        z = jnp.einsum('bhtd,bhsd->bhts', q[:, :, q0:kend], k[:, :, :kend]).astype(jnp.float32)
        t_idx = q0 + jnp.arange(SB_BLOCK)[:, None]
        s_idx = jnp.arange(kend)[None, :]
        strict = s_idx < t_idx
        log_keep = jnp.where(strict, jax.nn.log_sigmoid(-z), 0.0)
        suffix = lax.cumsum(log_keep, axis=3, reverse=True) - log_keep
        weights = jnp.where(strict, jnp.exp(jax.nn.log_sigmoid(z) + suffix), 0.0)
        outs.append(jnp.einsum('bhts,bhsd->bhtd', weights.astype(v.dtype), v[:, :, :kend]))
    o = jnp.concatenate(outs, axis=2).transpose(0, 2, 1, 3).reshape(bsz, s, SB_WIDTH)
    return (o * jax.nn.silu(gate)) @ w_out


def per_layer_embedding(h, p_i, norm_g, w_gate, w_proj):
    return h + (p_i @ w_proj) * jax.nn.sigmoid(rmsnorm(h, norm_g) @ w_gate)


def setup_inputs(seed: int = 0) -> dict:
    key = jax.random.key(seed)
    ks = jax.random.split(key, 24)

    def nrm(k, shape, scale):
        return jax.random.normal(k, shape, jnp.float32) * scale

    def gain(k, shape):
        return 1.0 + 0.05 * jax.random.normal(k, shape, jnp.float32)

    u = jax.random.uniform(ks[6], (N_A, SSM_HEADS), jnp.float32)
    dt = jnp.exp(u * (math.log(DT_MAX) - math.log(DT_MIN)) + math.log(DT_MIN))
    dt_bias = dt + jnp.log(-jnp.expm1(-dt))
    A_log = jnp.log(jax.random.uniform(ks[7], (N_A, SSM_HEADS), jnp.float32, minval=1.0, maxval=16.0))
    return {
        "x": nrm(ks[0], (BATCH, SEQ, D_MODEL), 1.0),
        "p": nrm(ks[1], (DEPTH, BATCH, SEQ, PLE_DIM), 1.0),
        "m_norm": gain(ks[2], (N_A, D_MODEL)),
        "m_in": nrm(ks[3], (N_A, D_MODEL, IN_PROJ_DIM), D_MODEL ** -0.5),
        "m_conv_w": nrm(ks[4], (N_A, CONV_K, CONV_DIM), CONV_K ** -0.5),
        "m_conv_b": nrm(ks[5], (N_A, CONV_DIM), 0.01),
        "m_dt_bias": dt_bias,
        "m_A_log": A_log,
        "m_D": gain(ks[8], (N_A, SSM_HEADS)),
        "m_ynorm": gain(ks[9], (N_A, D_INNER)),
        "m_out": nrm(ks[10], (N_A, D_INNER, D_MODEL), D_INNER ** -0.5),
        "kv_norm": gain(ks[11], (D_MODEL,)),
        "w_kv": nrm(ks[12], (D_MODEL, 2 * SB_WIDTH), D_MODEL ** -0.5),
        "k_norm": gain(ks[13], (SB_HEAD_DIM,)),
        "s_norm": gain(ks[14], (N_B, D_MODEL)),
        "s_in": nrm(ks[15], (N_B, D_MODEL, 2 * SB_WIDTH), D_MODEL ** -0.5),
        "q_norm": gain(ks[16], (N_B, SB_HEAD_DIM)),
        "s_out": nrm(ks[17], (N_B, SB_WIDTH, D_MODEL), SB_WIDTH ** -0.5),
        "ple_norm": gain(ks[18], (DEPTH, D_MODEL)),
        "ple_gate": nrm(ks[19], (DEPTH, D_MODEL, D_MODEL), D_MODEL ** -0.5),
        "ple_proj": nrm(ks[20], (DEPTH, PLE_DIM, D_MODEL), PLE_DIM ** -0.5),
    }


def reference(x, p, m_norm, m_in, m_conv_w, m_conv_b, m_dt_bias, m_A_log, m_D, m_ynorm, m_out,
              kv_norm, w_kv, k_norm, s_norm, s_in, q_norm, s_out, ple_norm, ple_gate, ple_proj):
    h = x
    k = v = None
    for i in range(DEPTH):
        if i < N_A:
            h = h + mamba2_mixer(h, m_norm[i], m_in[i], m_conv_w[i], m_conv_b[i], m_dt_bias[i],
                                 m_A_log[i], m_D[i], m_ynorm[i], m_out[i])
        else:
            if i == N_A:
                k, v = shared_kv(h, kv_norm, w_kv, k_norm)
            j = i - N_A
            h = h + stick_breaking_mixer(h, k, v, s_norm[j], s_in[j], q_norm[j], s_out[j])
        h = per_layer_embedding(h, p[i], ple_norm[i], ple_gate[i], ple_proj[i])
    return h
```

```cpp
#include <hip/hip_runtime.h>
#include <hip/hip_cooperative_groups.h>
#include <cstdio>
namespace cg = cooperative_groups;

#define LAS __attribute__((address_space(3)))
typedef unsigned short bf16_t;
typedef short bf16x8 __attribute__((ext_vector_type(8)));
typedef float f32x4 __attribute__((ext_vector_type(4)));
typedef float f32x16 __attribute__((ext_vector_type(16)));
typedef unsigned u32x4 __attribute__((ext_vector_type(4)));
typedef unsigned u32x2 __attribute__((ext_vector_type(2)));
typedef short s16x4 __attribute__((ext_vector_type(4)));

constexpr int T_TOK = 32768, DM = 1024, SEQ = 4096, NBATCH = 8;
constexpr int DI = 2048, NHS = 32, NIN = 5152, CONVD = 3072;
constexpr int ZW = 5120;
constexpr int N1P = 5376;
constexpr float EPS = 1e-6f;
constexpr int NTHREADS = 512;

constexpr size_t MiB = 1ull << 20;
constexpr size_t WS_W1T = 0;
constexpr size_t WS_W2T = WS_W1T + (size_t)N1P * 1024 * 2;
constexpr size_t WS_WG0 = WS_W2T + 4 * MiB;
constexpr size_t WS_WG1 = WS_WG0 + 2 * MiB;
constexpr size_t WS_WP0 = WS_WG1 + 2 * MiB;
constexpr size_t WS_WP1 = WS_WP0 + MiB / 2;
constexpr size_t WS_WKVQG = WS_WP1 + MiB / 2;
constexpr size_t WS_WSO = WS_WKVQG + 8 * MiB;
constexpr size_t WS_RA = 30 * MiB;
constexpr size_t WS_RB = WS_RA + 64 * MiB;
constexpr size_t WS_RZ = WS_RB + 64 * MiB;
constexpr size_t WS_DT = WS_RZ + 320 * MiB;
constexpr size_t WS_HSQ = WS_DT + 4 * MiB;
constexpr size_t WS_ST = WS_HSQ + 4 * MiB;
constexpr size_t WS_ST2 = WS_ST + 2 * MiB;
constexpr size_t WS_BAR = WS_ST2 + 2 * MiB;
constexpr size_t WS_ACH = WS_BAR + 16384;
constexpr size_t WS_DTH = WS_ACH + 4 * MiB;
constexpr size_t WS_SCH = WS_DTH + 4 * MiB;
constexpr size_t WS_DWH = WS_SCH + 4 * MiB;
constexpr size_t WS_END = WS_DWH + 4 * MiB;
static_assert(WS_WSO + 2 * MiB <= WS_RA, "weights overflow");
static_assert(WS_END <= 512 * MiB, "workspace overflow");

struct Params {
    const float* x; const float* p; const float* m_norm; const float* m_in; const float* m_conv_w; const float* m_conv_b;
    const float* m_dt_bias; const float* m_A_log; const float* m_D; const float* m_ynorm; const float* m_out;
    const float* kv_norm; const float* w_kv; const float* k_norm; const float* s_norm; const float* s_in; const float* q_norm;
    const float* s_out; const float* ple_norm; const float* ple_gate; const float* ple_proj;
    float* out; unsigned char* ws; int ph_lo, ph_hi;
};

typedef __bf16 bf16x2_t __attribute__((ext_vector_type(2)));
typedef float f32x2_t __attribute__((ext_vector_type(2)));
__device__ __forceinline__ unsigned cvt_pk_bf16(float lo, float hi) { f32x2_t v = {lo, hi}; bf16x2_t b = __builtin_convertvector(v, bf16x2_t); return __builtin_bit_cast(unsigned, b); }
__device__ __forceinline__ float bf_lo(unsigned u) { return __uint_as_float(u << 16); }
__device__ __forceinline__ float bf_hi(unsigned u) { return __uint_as_float(u & 0xffff0000u); }
__device__ __forceinline__ float bf2f(bf16_t b) { return __uint_as_float(((unsigned)b) << 16); }
__device__ __forceinline__ float silu_f(float v) { return v * __builtin_amdgcn_rcpf(1.0f + __expf(-v)); }
__device__ __forceinline__ float sigmoid_f(float v) { return __builtin_amdgcn_rcpf(1.0f + __expf(-v)); }
__device__ __forceinline__ u32x4 pack8(const float* v) { u32x4 r; r[0] = cvt_pk_bf16(v[0], v[1]); r[1] = cvt_pk_bf16(v[2], v[3]); r[2] = cvt_pk_bf16(v[4], v[5]); r[3] = cvt_pk_bf16(v[6], v[7]); return r; }

namespace pg8 {
constexpr int BM = 256, BK = 64, HALF = 128, HTB = HALF * BK * 2, STAGE_BYTES = 8 * HTB, NXCD = 8, WGM = 8;
__device__ __forceinline__ int lds_byte(int r, int c) { const int st = (r >> 4) * 2 + (c >> 5), rr = r & 15, cc = c & 31, ob = rr * 64 + cc * 2; return st * 1024 + (ob ^ (((ob >> 9) & 1) << 5)); }
__device__ __forceinline__ void stage_rc(int b, int& R, int& C) { const int st = b / 1024, sb = b % 1024, swz = sb ^ (((sb >> 9) & 1) << 5); R = (st >> 1) * 16 + swz / 64; C = (st & 1) * 32 + (swz % 64) / 2; }
__device__ __forceinline__ int perm32(int rho) { const int n = rho >> 4, i = rho & 15; return 8 * (i >> 2) + 4 * n + (i & 3); }
struct Unit { int pm, pn; };
struct Gemm { const bf16_t* A; const bf16_t* Bt; int M, N, K, lda; };
struct StaticOrder {
    int nM, nN, nwg, G, c;
    __device__ void init(int M, int N, int G_, int c_) { nM = M / BM; nN = N / BM; nwg = nM * nN; G = G_; c = c_; }
    __device__ bool next(int i, Unit& u) const {
        const long L = (long)i * G + c; if (L >= nwg) return false;
        int wgid = (int)L; { const int q = nwg / NXCD, r = nwg % NXCD, xcd = wgid % NXCD, off = wgid / NXCD; wgid = (xcd < r ? xcd * (q + 1) : r * (q + 1) + (xcd - r) * q) + off; }
        const int nig = WGM * nN, gid = wgid / nig, fm = gid * WGM, gsz = (nM - fm) < WGM ? (nM - fm) : WGM;
        u.pm = fm + ((wgid % nig) % gsz); u.pn = (wgid % nig) / gsz; return true;
    }
};
template <class Epi, bool TILEDA = false>
__device__ __forceinline__ void gemm_phase(LAS unsigned char* lds, const Gemm g, const StaticOrder& S, const Epi& E) {
    typename Epi::KState kst;
    const int tid = threadIdx.x, wid = __builtin_amdgcn_readfirstlane(tid >> 6), lane = tid & 63, wr = wid >> 2, wc = wid & 3, fr = lane & 15, fq = lane >> 4;
    const int K = g.K, nt = K / BK, lda = g.lda;
    unsigned voffA[2], voffB[2];
#pragma unroll
    for (int i = 0; i < 2; ++i) { int R, C; stage_rc(tid * 16 + i * 8192, R, C); const int Rb = (R & ~31) + perm32(R & 31);
        voffA[i] = (unsigned)(R * lda + C) * 2u; voffB[i] = (unsigned)(Rb * K + C) * 2u; }
    const size_t kstep = (size_t)(BK * 2), kstepA = TILEDA ? (size_t)(128 * 64 * 2) : (size_t)(BK * 2);
    const size_t hstepA = TILEDA ? (size_t)(32 * 128 * 64 * 2) : (size_t)HALF * lda * 2, hstepB = (size_t)HALF * K * 2;
    const size_t tstepA = 2 * hstepA, tstepB = 2 * hstepB;
    const unsigned ldsw = (unsigned)wid * 1024u;
    const int aoff = lds_byte(wr * 64 + fr, fq * 8), boff = lds_byte(wc * 32 + fr, fq * 8);
#define PG8_SA(b, h) (((b) * 2 + (h)) * HTB)
#define PG8_SB(b, h) ((4 + (b) * 2 + (h)) * HTB)
#define PG8_STAGE(bufoff, gbase, voff) do { _Pragma("unroll") for (int _i = 0; _i < 2; ++_i) \
        __builtin_amdgcn_global_load_lds((const unsigned*)((const char*)(gbase) + (voff)[_i]), (LAS unsigned*)(lds + (bufoff) + ldsw + _i * 8192), 16, 0, 0); } while (0)
#define PG8_LDA(dst, b, h) do { _Pragma("unroll") for (int m = 0; m < 4; ++m) _Pragma("unroll") for (int k = 0; k < 2; ++k) dst[m][k] = *(const LAS bf16x8*)(lds + PG8_SA(b, h) + aoff + m * 2048 + k * 1024); } while (0)
#define PG8_LDB(dst, b, h) do { _Pragma("unroll") for (int n = 0; n < 2; ++n) _Pragma("unroll") for (int k = 0; k < 2; ++k) dst[n][k] = *(const LAS bf16x8*)(lds + PG8_SB(b, h) + boff + n * 2048 + k * 1024); } while (0)
#define PG8_MMA(ai, bj, At, Bt) do { __builtin_amdgcn_s_setprio(1); _Pragma("unroll") for (int m = 0; m < 4; ++m) _Pragma("unroll") for (int n = 0; n < 2; ++n) _Pragma("unroll") for (int k = 0; k < 2; ++k) \
        acc[ai][bj][m][n] = __builtin_amdgcn_mfma_f32_16x16x32_bf16(Bt[n][k], At[m][k], acc[ai][bj][m][n], 0, 0, 0); __builtin_amdgcn_s_setprio(0); } while (0)
#define PG8_WAIT_V(n) asm volatile("s_waitcnt vmcnt(" #n ")" ::: "memory")
#define PG8_WAIT_L(n) asm volatile("s_waitcnt lgkmcnt(" #n ")" ::: "memory")
#define PG8_BAR __builtin_amdgcn_s_barrier()
#define PG8_SCHED __builtin_amdgcn_sched_barrier(0)
    Unit cur, nxt; int ui = 0;
    if (!S.next(0, cur)) return;
    f32x4 acc[2][2][4][2];
#pragma unroll
    for (int a = 0; a < 2; ++a)
#pragma unroll
        for (int b = 0; b < 2; ++b)
#pragma unroll
            for (int m = 0; m < 4; ++m)
#pragma unroll
                for (int n = 0; n < 2; ++n) acc[a][b][m][n] = (f32x4){0.f, 0.f, 0.f, 0.f};
    bf16x8 At[4][2], B0[2][2], B1[2][2];
    const char* cA = (const char*)g.A + (size_t)cur.pm * tstepA; const char* cB = (const char*)g.Bt + (size_t)cur.pn * tstepB;
    PG8_STAGE(PG8_SB(0, 0), cB, voffB); PG8_STAGE(PG8_SA(0, 0), cA, voffA); PG8_STAGE(PG8_SB(0, 1), cB + hstepB, voffB); PG8_STAGE(PG8_SA(0, 1), cA + hstepA, voffA);
    if (wr == 1) PG8_BAR;
    PG8_WAIT_V(4); PG8_BAR;
    PG8_STAGE(PG8_SB(1, 0), cB + kstep, voffB); PG8_STAGE(PG8_SA(1, 0), cA + kstepA, voffA); PG8_STAGE(PG8_SB(1, 1), cB + hstepB + kstep, voffB);
    PG8_WAIT_V(6); PG8_BAR;
    for (;;) {
        const bool has_next = S.next(ui + 1, nxt);
        const char* nA = has_next ? (const char*)g.A + (size_t)nxt.pm * tstepA : cA; const char* nB = has_next ? (const char*)g.Bt + (size_t)nxt.pn * tstepB : cB;
        E.kbegin(kst, cur, wr, fr, fq);
        for (int t = 0; t < nt; t += 2) {
            const bool last = (t == nt - 2);
            E.kstep(kst, t, acc);
            const char* a1 = cA + (size_t)(t + 1) * kstepA;
            const char* a2 = last ? nA : cA + (size_t)(t + 2) * kstepA; const char* b2 = last ? nB : cB + (size_t)(t + 2) * kstep;
            const char* a3 = a2 + kstepA; const char* b3 = b2 + kstep;
            PG8_LDB(B0, 0, 0); PG8_SCHED; PG8_LDA(At, 0, 0); PG8_STAGE(PG8_SA(1, 1), a1 + hstepA, voffA);
            PG8_WAIT_L(8); PG8_BAR; PG8_WAIT_L(0); PG8_MMA(0, 0, At, B0); PG8_BAR; PG8_SCHED;
            PG8_LDB(B1, 0, 1); PG8_STAGE(PG8_SB(0, 0), b2, voffB);
            PG8_BAR; PG8_WAIT_L(0); PG8_MMA(0, 1, At, B1); PG8_BAR;
            PG8_LDA(At, 0, 1); PG8_STAGE(PG8_SA(0, 0), a2, voffA);
            PG8_BAR; PG8_WAIT_L(0); PG8_MMA(1, 0, At, B0); PG8_BAR; PG8_SCHED;
            PG8_STAGE(PG8_SB(0, 1), b2 + hstepB, voffB);
            PG8_WAIT_V(6); PG8_BAR; PG8_MMA(1, 1, At, B1); PG8_BAR;
            PG8_LDB(B0, 1, 0); PG8_SCHED; PG8_LDA(At, 1, 0); PG8_STAGE(PG8_SA(0, 1), a2 + hstepA, voffA);
            PG8_WAIT_L(8); PG8_BAR; PG8_WAIT_L(0); PG8_MMA(0, 0, At, B0); PG8_BAR; PG8_SCHED;
            PG8_LDB(B1, 1, 1); PG8_STAGE(PG8_SB(1, 0), b3, voffB);
            PG8_BAR; PG8_WAIT_L(0); PG8_MMA(0, 1, At, B1); PG8_BAR;
            PG8_LDA(At, 1, 1); PG8_STAGE(PG8_SA(1, 0), a3, voffA);
            PG8_BAR; PG8_WAIT_L(0); PG8_MMA(1, 0, At, B0); PG8_BAR; PG8_SCHED;
            PG8_STAGE(PG8_SB(1, 1), b3 + hstepB, voffB);
            PG8_WAIT_V(6); PG8_BAR; PG8_MMA(1, 1, At, B1); PG8_BAR;
        }
        E(acc, cur, wr, wc, fr, fq, kst);
        if (!has_next) break;
#pragma unroll
        for (int a = 0; a < 2; ++a)
#pragma unroll
            for (int b = 0; b < 2; ++b)
#pragma unroll
                for (int m = 0; m < 4; ++m)
#pragma unroll
                    for (int n = 0; n < 2; ++n) acc[a][b][m][n] = (f32x4){0.f, 0.f, 0.f, 0.f};
        cur = nxt; cA = nA; cB = nB; ++ui;
    }
    PG8_WAIT_V(0);
    if (wr == 0) PG8_BAR;
    PG8_BAR;
#undef PG8_SA
#undef PG8_SB
#undef PG8_STAGE
#undef PG8_LDA
#undef PG8_LDB
#undef PG8_MMA
#undef PG8_WAIT_V
#undef PG8_WAIT_L
#undef PG8_BAR
#undef PG8_SCHED
}
}
typedef f32x4 AccT[2][2][4][2];

constexpr size_t RZ_XR = 128 * MiB, RZ_BCR = 256 * MiB;
struct EpiZ {
    struct KState {}; __device__ __forceinline__ void kbegin(KState&, const pg8::Unit&, int, int, int) const {} __device__ __forceinline__ void kstep(KState&, int, AccT&) const {}
    bf16_t* ZT; bf16_t* XR; bf16_t* BCR;
    __device__ __forceinline__ void operator()(const AccT& acc, const pg8::Unit& u, int wr, int wc, int fr, int fq, const KState&) const {
        const int row0 = u.pm * 256 + wr * 64 + fr; const bool act = u.pn < 8;
        if (u.pn < 16) {
            bf16_t* base = act ? ZT : XR; const int hc = (u.pn & 7) * 256 + wc * 32 + 8 * fq;
#pragma unroll
            for (int ai = 0; ai < 2; ++ai)
#pragma unroll
                for (int m = 0; m < 4; ++m) { const int row = row0 + ai * 128 + m * 16;
#pragma unroll
                    for (int bj = 0; bj < 2; ++bj) { f32x4 v0 = acc[ai][bj][m][0], v1 = acc[ai][bj][m][1]; const int c = hc + bj * 128;
                        if (act) {
#pragma unroll
                            for (int j = 0; j < 4; ++j) { v0[j] = silu_f(v0[j]); v1[j] = silu_f(v1[j]); } }
                        u32x4 o; o[0] = cvt_pk_bf16(v0[0], v0[1]); o[1] = cvt_pk_bf16(v0[2], v0[3]); o[2] = cvt_pk_bf16(v1[0], v1[1]); o[3] = cvt_pk_bf16(v1[2], v1[3]);
                        *(u32x4*)(base + ((size_t)((row >> 7) * 32 + (c >> 6)) * 128 + (row & 127)) * 64 + (c & 63)) = o; } }
        } else {
            const int c0 = (u.pn - 16) * 256 + wc * 32 + 8 * fq;
#pragma unroll
            for (int ai = 0; ai < 2; ++ai)
#pragma unroll
                for (int m = 0; m < 4; ++m) { bf16_t* rowp = BCR + (size_t)(row0 + ai * 128 + m * 16) * 1024 + c0;
#pragma unroll
                    for (int bj = 0; bj < 2; ++bj) { const f32x4 v0 = acc[ai][bj][m][0], v1 = acc[ai][bj][m][1];
                        u32x4 o; o[0] = cvt_pk_bf16(v0[0], v0[1]); o[1] = cvt_pk_bf16(v0[2], v0[3]); o[2] = cvt_pk_bf16(v1[0], v1[1]); o[3] = cvt_pk_bf16(v1[2], v1[3]);
                        *(u32x4*)(rowp + bj * 128) = o; } }
        }
    }
};
struct EpiBf {
    struct KState {}; __device__ __forceinline__ void kbegin(KState&, const pg8::Unit&, int, int, int) const {} __device__ __forceinline__ void kstep(KState&, int, AccT&) const {}
    bf16_t* O; int ldo;
    __device__ __forceinline__ void operator()(const AccT& acc, const pg8::Unit& u, int wr, int wc, int fr, int fq, const KState&) const {
        const int row0 = u.pm * 256 + wr * 64 + fr, col0 = u.pn * 256 + wc * 32 + 8 * fq;
#pragma unroll
        for (int ai = 0; ai < 2; ++ai)
#pragma unroll
            for (int m = 0; m < 4; ++m) { bf16_t* rowp = O + (size_t)(row0 + ai * 128 + m * 16) * ldo + col0;
#pragma unroll
                for (int bj = 0; bj < 2; ++bj) { const f32x4 v0 = acc[ai][bj][m][0], v1 = acc[ai][bj][m][1];
                    u32x4 o; o[0] = cvt_pk_bf16(v0[0], v0[1]); o[1] = cvt_pk_bf16(v0[2], v0[3]); o[2] = cvt_pk_bf16(v1[0], v1[1]); o[3] = cvt_pk_bf16(v1[2], v1[3]);
                    *(u32x4*)(rowp + bj * 128) = o; } }
    }
};
__device__ __forceinline__ void rows_rstd(const float* st, int row0, int fq, float (&rs)[8]) {
    f32x4 sv[8];
#pragma unroll
    for (int i = 0; i < 8; ++i) sv[i] = *(const f32x4*)(st + (size_t)(row0 + (i >> 2) * 128 + (i & 3) * 16) * 16 + 4 * fq);
#pragma unroll
    for (int i = 0; i < 8; ++i) { float t = (sv[i][0] + sv[i][1]) + (sv[i][2] + sv[i][3]); t += __shfl_xor(t, 16); t += __shfl_xor(t, 32); rs[i] = rsqrtf(t * (1.0f / DM) + EPS); }
}
template <bool RES_F32, bool PLE, bool OUT_F32, bool GNORM = false>
struct EpiH {
    struct KState {};
    const float* hsq; LAS float* rtab;
    __device__ __forceinline__ void kbegin(KState&, const pg8::Unit& u, int wr, int fr, int fq) const {
        if (GNORM) { const int row0 = u.pm * 256 + wr * 64 + fr; LAS float* tb = rtab + (threadIdx.x >> 6) * 512 + (threadIdx.x & 63);
#pragma unroll
            for (int hlf = 0; hlf < 2; ++hlf) { f32x4 a[4], b[4];
#pragma unroll
                for (int i = 0; i < 4; ++i) { const size_t row = (size_t)(row0 + hlf * 128 + i * 16); a[i] = *(const f32x4*)(hsq + row * 32 + 8 * fq); b[i] = *(const f32x4*)(hsq + row * 32 + 8 * fq + 4); }
#pragma unroll
                for (int i = 0; i < 4; ++i) tb[(hlf * 4 + i) * 64] = rsqrtf(((a[i][0] + a[i][1] + a[i][2] + a[i][3]) + (b[i][0] + b[i][1] + b[i][2] + b[i][3])) * (1.0f / 512.0f) + EPS); } }
    }
    __device__ __forceinline__ void kstep(KState&, int t, AccT& acc) const {
        if (GNORM) { if (t == 8 || t == 16 || t == 24) { const int gdone = (t >> 3) - 1; const int fr = threadIdx.x & 15;
            const LAS float* tb = rtab + (threadIdx.x >> 6) * 512 + fr + 16 * gdone;
#pragma unroll
                for (int i = 0; i < 8; ++i) { const float rg = tb[i * 64], rn = tb[i * 64 + 16]; const float f = rg * __builtin_amdgcn_rcpf(rn);
                    const int ai = i >> 2, m = i & 3;
#pragma unroll
                    for (int bj = 0; bj < 2; ++bj)
#pragma unroll
                        for (int n = 0; n < 2; ++n) acc[ai][bj][m][n] *= f; } } }
    }
    const float* res32; const bf16_t* resb; int ldres;
    const bf16_t* pp; int ldpp; const float* st_in;
    float* out32; bf16_t* hb; int ldhb; float* st_out;
    __device__ __forceinline__ void operator()(const AccT& acc, const pg8::Unit& u, int wr, int wc, int fr, int fq, const KState& kst) const {
        const int row0 = u.pm * 256 + wr * 64 + fr, col0 = u.pn * 256 + wc * 32 + 8 * fq;
        float rs[8];
        if (PLE) rows_rstd(st_in, row0, fq, rs);
        if (GNORM) { const LAS float* tb = rtab + (threadIdx.x >> 6) * 512 + fr + 48;
#pragma unroll
            for (int i = 0; i < 8; ++i) rs[i] = tb[i * 64]; }
#pragma unroll
        for (int g2 = 0; g2 < 4; ++g2) { const int ai = g2 >> 1, mb = (g2 & 1) * 2;
            f32x4 rf[2][2][2]; u32x4 rbv[2][2]; u32x4 pv[2][2];
#pragma unroll
            for (int mm = 0; mm < 2; ++mm) { const int row = row0 + ai * 128 + (mb + mm) * 16;
#pragma unroll
                for (int bj = 0; bj < 2; ++bj) {
                    if (RES_F32) { const float* rp = res32 + (size_t)row * DM + col0 + bj * 128; rf[mm][bj][0] = *(const f32x4*)rp; rf[mm][bj][1] = *(const f32x4*)(rp + 4); }
                    else rbv[mm][bj] = *(const u32x4*)(resb + (size_t)row * ldres + col0 + bj * 128);
                    if (PLE) pv[mm][bj] = *(const u32x4*)(pp + (size_t)row * ldpp + col0 + bj * 128); } }
#pragma unroll
            for (int mm = 0; mm < 2; ++mm) { const int m = mb + mm; const int row = row0 + ai * 128 + m * 16; float ss = 0.f;
#pragma unroll
                for (int bj = 0; bj < 2; ++bj) { float v[8], r[8];
                    if (RES_F32) {
#pragma unroll
                        for (int e = 0; e < 4; ++e) { r[e] = rf[mm][bj][0][e]; r[4 + e] = rf[mm][bj][1][e]; } }
                    else {
#pragma unroll
                        for (int e = 0; e < 4; ++e) { r[2 * e] = bf_lo(rbv[mm][bj][e]); r[2 * e + 1] = bf_hi(rbv[mm][bj][e]); } }
#pragma unroll
                    for (int e = 0; e < 8; ++e) { const float a = acc[ai][bj][m][e >> 2][e & 3];
                        if (PLE) { const unsigned w = pv[mm][bj][e >> 1]; const float pe = (e & 1) ? bf_hi(w) : bf_lo(w); v[e] = r[e] + pe * sigmoid_f(rs[ai * 4 + m] * a); }
                        else v[e] = r[e] + (GNORM ? rs[ai * 4 + m] * a : a);
                        ss += v[e] * v[e]; }
                    if (OUT_F32) { float* op = out32 + (size_t)row * DM + col0 + bj * 128;
                        *(f32x4*)op = (f32x4){v[0], v[1], v[2], v[3]}; *(f32x4*)(op + 4) = (f32x4){v[4], v[5], v[6], v[7]}; }
                    if (hb) *(u32x4*)(hb + (size_t)row * ldhb + col0 + bj * 128) = pack8(v); }
                if (st_out) { ss += __shfl_xor(ss, 16); ss += __shfl_xor(ss, 32);
                    if (fq == 0) st_out[(size_t)row * 16 + u.pn * 4 + wc] = ss; } }
        }
    }
};
struct EpiKvqg {
    struct KState {}; __device__ __forceinline__ void kbegin(KState&, const pg8::Unit&, int, int, int) const {} __device__ __forceinline__ void kstep(KState&, int, AccT&) const {}
    const float* st_in; bf16_t* Kb; bf16_t* VT; bf16_t* Qb; bf16_t* Gb; const float* k_g; const float* q_g;
    __device__ __forceinline__ void operator()(const AccT& acc, const pg8::Unit& u, int wr, int wc, int fr, int fq, const KState&) const {
        const int row0 = u.pm * 256 + wr * 64 + fr; const int sec = u.pn >> 2, head = 4 * (u.pn & 3) + wc;
        float rsv[8]; rows_rstd(st_in, row0, fq, rsv);
        float gnv[2][8];
        if (sec == 0 || sec == 2) { const float* gn = sec == 0 ? k_g : q_g;
#pragma unroll
            for (int bj = 0; bj < 2; ++bj)
#pragma unroll
                for (int e = 0; e < 8; ++e) gnv[bj][e] = gn[32 * bj + 8 * fq + e]; }
#pragma unroll
        for (int ai = 0; ai < 2; ++ai)
#pragma unroll
            for (int m = 0; m < 4; ++m) { const int row = row0 + ai * 128 + m * 16; const float rs = rsv[ai * 4 + m];
                const int b = row >> 12, s = row & 4095;
                float v[2][8];
#pragma unroll
                for (int bj = 0; bj < 2; ++bj)
#pragma unroll
                    for (int n = 0; n < 2; ++n)
#pragma unroll
                        for (int j = 0; j < 4; ++j) v[bj][4 * n + j] = acc[ai][bj][m][n][j] * rs;
                if (sec == 0 || sec == 2) {
                    float ss = 0.f;
#pragma unroll
                    for (int bj = 0; bj < 2; ++bj)
#pragma unroll
                        for (int e = 0; e < 8; ++e) ss += v[bj][e] * v[bj][e];
                    ss += __shfl_xor(ss, 16); ss += __shfl_xor(ss, 32);
                    const float r = rsqrtf(ss * (1.0f / 64.0f) + EPS) * (sec == 2 ? 0.125f * 1.4426950408889634f : 1.0f);
                    bf16_t* dst = (sec == 0 ? Kb : Qb) + ((size_t)(b * 16 + head) * SEQ + s) * 64;
#pragma unroll
                    for (int bj = 0; bj < 2; ++bj) { const int d0 = 32 * bj + 8 * fq; float w[8];
#pragma unroll
                        for (int e = 0; e < 8; ++e) w[e] = v[bj][e] * r * gnv[bj][e];
                        *(u32x4*)(dst + d0) = pack8(w); }
                } else if (sec == 1) {
                    bf16_t* dst = VT + ((size_t)(b * 16 + head) * SEQ + s) * 64;
#pragma unroll
                    for (int bj = 0; bj < 2; ++bj) { const int d0 = 32 * bj + 8 * fq; *(u32x4*)(dst + d0) = pack8(v[bj]); }
                } else {
#pragma unroll
                    for (int bj = 0; bj < 2; ++bj) { const int d0 = 32 * bj + 8 * fq; float w[8];
#pragma unroll
                        for (int e = 0; e < 8; ++e) w[e] = silu_f(v[bj][e]);
                        *(u32x4*)(Gb + (size_t)row * DM + head * 64 + d0) = pack8(w); }
                }
            }
    }
};

template <class F>
__device__ __forceinline__ void wt_cvt(bf16_t* dst, int Ndst, int K, long gtid, long gth, F src) {
    const long items = (long)Ndst * (K / 8);
    for (long i0 = gtid; i0 < items; i0 += 2 * gth) { float v[2][8];
#pragma unroll
        for (int u = 0; u < 2; ++u) { const long i = i0 + u * gth; if (i < items) { const int n = (int)(i % Ndst), k0 = (int)(i / Ndst) * 8;
#pragma unroll
                for (int e = 0; e < 8; ++e) v[u][e] = src(n, k0 + e); } }
#pragma unroll
        for (int u = 0; u < 2; ++u) { const long i = i0 + u * gth; if (i < items) { const int n = (int)(i % Ndst), k0 = (int)(i / Ndst) * 8;
                *(u32x4*)(dst + (size_t)n * K + k0) = pack8(v[u]); } } }
}
__device__ __forceinline__ void phase_prep(const Params& P) {
    unsigned char* ws = P.ws;
    const long gtid = (long)blockIdx.x * NTHREADS + threadIdx.x, gth = (long)gridDim.x * NTHREADS;
    { const float* w = P.m_in; wt_cvt((bf16_t*)(ws + WS_W1T), NIN, 1024, gtid, gth, [=](int n, int k) { return w[(size_t)k * NIN + n]; }); }
    { const float* w = P.m_out; const float* g = P.m_ynorm; wt_cvt((bf16_t*)(ws + WS_W2T), 1024, 2048, gtid, gth, [=](int n, int k) { return w[(size_t)k * 1024 + n] * g[k]; }); }
    for (int i = 0; i < 2; ++i) { const float* w = P.ple_gate + (size_t)i * 1024 * 1024; const float* g = P.ple_norm + i * 1024;
        wt_cvt((bf16_t*)(ws + (i ? WS_WG1 : WS_WG0)), 1024, 1024, gtid, gth, [=](int n, int k) { return w[(size_t)k * 1024 + n] * g[k]; });
        const float* wp = P.ple_proj + (size_t)i * 256 * 1024;
        wt_cvt((bf16_t*)(ws + (i ? WS_WP1 : WS_WP0)), 1024, 256, gtid, gth, [=](int n, int k) { return wp[(size_t)k * 1024 + n]; }); }
    { const float* wkv = P.w_kv; const float* gkv = P.kv_norm; const float* wq = P.s_in; const float* gq = P.s_norm;
        wt_cvt((bf16_t*)(ws + WS_WKVQG), 4096, 1024, gtid, gth, [=](int n, int k) {
            const int pn = n >> 8, cl = n & 255, bj = cl >> 7, wc = (cl >> 5) & 3, i = cl & 31, sec = pn >> 2, head = 4 * (pn & 3) + wc, d = 32 * bj + i;
            const int sc = (sec & 1) * 1024 + head * 64 + d;
            return sec < 2 ? wkv[(size_t)k * 2048 + sc] * gkv[k] : wq[(size_t)k * 2048 + sc] * gq[k]; }); }
    { const float* w = P.s_out; wt_cvt((bf16_t*)(ws + WS_WSO), 1024, 1024, gtid, gth, [=](int n, int k) { return w[(size_t)k * 1024 + n]; }); }
    const int lane = threadIdx.x & 63; const int gw = (int)(gtid >> 6), nw = (int)(gth >> 6);
    bf16_t* u0 = (bf16_t*)(ws + WS_RA);
    f32x4 gm[4];
#pragma unroll
    for (int i = 0; i < 4; ++i) gm[i] = *(const f32x4*)(P.m_norm + i * 256 + lane * 4);
    for (int rowb = gw * 4; rowb < T_TOK; rowb += nw * 4) { f32x4 v[4][4];
#pragma unroll
        for (int r = 0; r < 4; ++r)
#pragma unroll
            for (int i = 0; i < 4; ++i) v[r][i] = *(const f32x4*)(P.x + (size_t)(rowb + r) * DM + i * 256 + lane * 4);
#pragma unroll
        for (int r = 0; r < 4; ++r) { float ss = 0.f;
#pragma unroll
            for (int i = 0; i < 4; ++i) ss += v[r][i][0] * v[r][i][0] + v[r][i][1] * v[r][i][1] + v[r][i][2] * v[r][i][2] + v[r][i][3] * v[r][i][3];
#pragma unroll
            for (int o = 1; o < 64; o <<= 1) ss += __shfl_xor(ss, o);
            const float rs = rsqrtf(ss * (1.0f / DM) + EPS);
#pragma unroll
            for (int i = 0; i < 4; ++i) { u32x2 o;
                o[0] = cvt_pk_bf16(v[r][i][0] * rs * gm[i][0], v[r][i][1] * rs * gm[i][1]); o[1] = cvt_pk_bf16(v[r][i][2] * rs * gm[i][2], v[r][i][3] * rs * gm[i][3]);
                *(u32x2*)(u0 + (size_t)(rowb + r) * DM + i * 256 + lane * 4) = o; } } }
}

__device__ __forceinline__ void phase_dt(const Params& P) {
    const bf16_t* u0 = (const bf16_t*)(P.ws + WS_RA); const bf16_t* Wdt = (const bf16_t*)(P.ws + WS_W1T) + (size_t)5120 * 1024; float* DT = (float*)(P.ws + WS_DT);
    const int tid = threadIdx.x, w = tid >> 6, lane = tid & 63, h2 = lane >> 5, r32 = lane & 31;
    for (int tile = blockIdx.x + gridDim.x * w; tile < T_TOK / 32; tile += gridDim.x * 8) {
        const bf16_t* ap = u0 + (size_t)(tile * 32 + r32) * 1024 + 8 * h2; const bf16_t* bp = Wdt + (size_t)r32 * 1024 + 8 * h2;
        f32x16 acc;
#pragma unroll
        for (int i = 0; i < 16; ++i) acc[i] = 0.f;
#pragma unroll 8
        for (int ks = 0; ks < 64; ++ks) { const bf16x8 a = *(const bf16x8*)(ap + 16 * ks); const bf16x8 bw = *(const bf16x8*)(bp + 16 * ks);
            acc = __builtin_amdgcn_mfma_f32_32x32x16_bf16(a, bw, acc, 0, 0, 0); }
        const float bias = P.m_dt_bias[r32];
#pragma unroll
        for (int r = 0; r < 16; ++r) { const int row = tile * 32 + (r & 3) + 8 * (r >> 2) + 4 * h2; const float xx = acc[r] + bias;
            DT[(size_t)row * 32 + r32] = xx > 20.f ? xx : log1pf(__expf(xx)); }
    }
}

__device__ __forceinline__ void phase_conv(const Params& P) {
    unsigned char* ws = P.ws;
    const long gtid = (long)blockIdx.x * NTHREADS + threadIdx.x, gth = (long)gridDim.x * NTHREADS;
    const bf16_t* BCR = (const bf16_t*)(ws + WS_RZ + RZ_BCR); bf16_t* BC = (bf16_t*)(ws + WS_RB);
    {
      const int cgi = (int)(gtid & 127), ch = 2048 + cgi * 8; const long nitem = (long)(T_TOK / 8) * 128;
      float cw[4][8], cb[8];
#pragma unroll
      for (int j = 0; j < 4; ++j) { const f32x4 a = *(const f32x4*)(P.m_conv_w + j * CONVD + ch), b = *(const f32x4*)(P.m_conv_w + j * CONVD + ch + 4);
#pragma unroll
          for (int e = 0; e < 4; ++e) { cw[j][e] = a[e]; cw[j][4 + e] = b[e]; } }
      { const f32x4 a = *(const f32x4*)(P.m_conv_b + ch), b = *(const f32x4*)(P.m_conv_b + ch + 4);
#pragma unroll
          for (int e = 0; e < 4; ++e) { cb[e] = a[e]; cb[4 + e] = b[e]; } }
      for (long it0 = gtid; it0 < nitem; it0 += 2 * gth) {
        u32x4 raw[2][11];
#pragma unroll
        for (int u = 0; u < 2; ++u) { const long it = it0 + u * gth; if (it < nitem) { const int tg = (int)(it >> 7), t0 = tg * 8, s0 = t0 & 4095;
#pragma unroll
            for (int r = 0; r < 11; ++r) { if (s0 - 3 + r >= 0) raw[u][r] = *(const u32x4*)(BCR + (size_t)(t0 - 3 + r) * 1024 + cgi * 8); else raw[u][r] = (u32x4){0u, 0u, 0u, 0u}; } } }
#pragma unroll
        for (int u = 0; u < 2; ++u) { const long it = it0 + u * gth; if (it < nitem) { const int tg = (int)(it >> 7), t0 = tg * 8;
#pragma unroll
          for (int r = 0; r < 8; ++r) { float o[8];
#pragma unroll
            for (int e = 0; e < 8; ++e) { float a = cb[e];
#pragma unroll
                for (int j = 0; j < 4; ++j) { const unsigned w = raw[u][r + j][e >> 1]; a += cw[j][e] * ((e & 1) ? bf_hi(w) : bf_lo(w)); }
                o[e] = silu_f(a); }
            *(u32x4*)(BC + (size_t)(t0 + r) * 1024 + cgi * 8) = pack8(o); } } }
      } }
    { const float* DTg = (const float*)(ws + WS_DT); float* ACh = (float*)(ws + WS_ACH); float* DTh = (float*)(ws + WS_DTH); float* SCh = (float*)(ws + WS_SCH); float* DWh = (float*)(ws + WS_DWH);
      const int lane = threadIdx.x & 63; const int gw = (int)(gtid >> 6), nw = (int)(gth >> 6);
      for (int it = gw; it < NBATCH * NHS * 32; it += nw) { const int h = it & 31, c = (it >> 5) & 31, b = it >> 10; const int t0 = b * SEQ + c * 128;
        const float Ah = -__expf(P.m_A_log[h]);
        const float d0 = DTg[(size_t)(t0 + lane) * 32 + h], d1 = DTg[(size_t)(t0 + 64 + lane) * 32 + h];
        float a0 = d0 * Ah, a1 = d1 * Ah;
#pragma unroll
        for (int o = 1; o < 64; o <<= 1) { const float t = __shfl_up(a0, o); if (lane >= o) a0 += t; }
#pragma unroll
        for (int o = 1; o < 64; o <<= 1) { const float t = __shfl_up(a1, o); if (lane >= o) a1 += t; }
        a1 += __shfl(a0, 63);
        const float ae = __shfl(a1, 63);
        const size_t o0 = (size_t)(b * 32 + h) * SEQ + c * 128 + lane;
        const float e0 = __shfl(a0, lane | 15), e1 = __shfl(a1, lane | 15);
        ACh[o0] = a0; ACh[o0 + 64] = a1; DTh[o0] = d0; DTh[o0 + 64] = d1; SCh[o0] = d0 * __expf(ae - a0); SCh[o0 + 64] = d1 * __expf(ae - a1);
        DWh[o0] = d0 * __expf(e0 - a0); DWh[o0 + 64] = d1 * __expf(e1 - a1); } }
    bf16_t* pb = (bf16_t*)(ws + WS_RA);
    { const long npb = (long)2 * T_TOK * 256 / 8;
      for (long it0 = gtid; it0 < npb; it0 += 4 * gth) { f32x4 a[4], b[4];
#pragma unroll
        for (int u = 0; u < 4; ++u) { const long it = it0 + u * gth; if (it < npb) { a[u] = *(const f32x4*)(P.p + it * 8); b[u] = *(const f32x4*)(P.p + it * 8 + 4); } }
#pragma unroll
        for (int u = 0; u < 4; ++u) { const long it = it0 + u * gth; if (it < npb) { u32x4 o; o[0] = cvt_pk_bf16(a[u][0], a[u][1]); o[1] = cvt_pk_bf16(a[u][2], a[u][3]); o[2] = cvt_pk_bf16(b[u][0], b[u][1]); o[3] = cvt_pk_bf16(b[u][2], b[u][3]);
            *(u32x4*)(pb + it * 8) = o; } } } }
}

constexpr int SROW = 272;
constexpr int L_B = 0, L_C = 34816, L_XW = 69632  , L_XT = 104448, L_ST = 121856  , L_AC = 156672  , L_SSD_END = 157696;
constexpr int LDS_BYTES = 158720;
static_assert(L_SSD_END <= LDS_BYTES - 16 && pg8::STAGE_BYTES + 16384 <= LDS_BYTES - 16, "LDS");

__device__ __forceinline__ void phase_ssd(const Params& P, LAS unsigned char* lds) {
    unsigned char* ws = P.ws;
    bf16_t* Z = (bf16_t*)(ws + WS_RZ); const bf16_t* BC = (const bf16_t*)(ws + WS_RB);
    const float* ACh = (const float*)(ws + WS_ACH); const float* DTh = (const float*)(ws + WS_DTH); const float* SCh = (const float*)(ws + WS_SCH); const float* DWh = (const float*)(ws + WS_DWH); float* HSQ = (float*)(ws + WS_HSQ);
    const int tid = threadIdx.x, w = __builtin_amdgcn_readfirstlane(tid >> 6), lane = tid & 63, q = lane >> 4, r16 = lane & 15;
    const int lt = w < 4 ? w : 11 - w;
    for (int item = blockIdx.x; item < NBATCH * NHS; item += gridDim.x) {
        const int bg = (item & 7) * 4 + (item >> 6), g = bg & 3, b = bg >> 2, h = g * 8 + ((item >> 3) & 7);
        const float Ah = -__expf(P.m_A_log[h]), Dh = P.m_D[h];
        const bf16_t* XR = (const bf16_t*)(ws + WS_RZ + RZ_XR);
        float cwx[4]; const int xch = h * 64 + lane;
#pragma unroll
        for (int j = 0; j < 4; ++j) cwx[j] = P.m_conv_w[j * CONVD + xch];
        const float cbx = P.m_conv_b[xch];
        const bf16x2_t w01 = __builtin_bit_cast(bf16x2_t, cvt_pk_bf16(cwx[0], cwx[1])), w23 = __builtin_bit_cast(bf16x2_t, cvt_pk_bf16(cwx[2], cwx[3]));
        f32x4 stT[4];
#pragma unroll
        for (int pt = 0; pt < 4; ++pt) stT[pt] = (f32x4){0.f, 0.f, 0.f, 0.f};
        __syncthreads();
        for (int i = tid; i < 2 * 64 * SROW / 4; i += NTHREADS) ((LAS unsigned*)(lds + L_ST))[i] = 0u;
        u32x4 rb[4], rc[4]; bf16_t xraw[19]; float pac = 0.f, pdt = 0.f, pdw = 0.f; f32x4 psx[4];
        const float* ach = ACh + (size_t)(b * 32 + h) * SEQ; const float* dth = DTh + (size_t)(b * 32 + h) * SEQ; const float* sch = SCh + (size_t)(b * 32 + h) * SEQ; const float* dwh = DWh + (size_t)(b * 32 + h) * SEQ;
#define SSD_LOAD(cc) do { const int _t0 = b * SEQ + (cc) * 128; \
            _Pragma("unroll") for (int i = 0; i < 4; ++i) { const int piece = tid + 512 * i, row = piece >> 4, c16 = piece & 15; \
                rb[i] = *(const u32x4*)(BC + (size_t)(_t0 + row) * 1024 + g * 128 + c16 * 8); \
                rc[i] = *(const u32x4*)(BC + (size_t)(_t0 + row) * 1024 + 512 + g * 128 + c16 * 8); \
                } \
            _Pragma("unroll") for (int i = 0; i < 19; ++i) { const int sl = 16 * w - 3 + i; \
                const int tk = (cc) * 128 + sl; if ((cc) == 0 && sl < 0) xraw[i] = 0; else xraw[i] = XR[((size_t)((b * 32 + (tk >> 7)) * 32 + h) * 128 + (tk & 127)) * 64 + lane]; } \
            _Pragma("unroll") for (int i = 0; i < 4; ++i) psx[i] = *(const f32x4*)(sch + (cc) * 128 + 16 * w + 4 * i); \
            if (tid < 128) { pac = ach[(cc) * 128 + tid]; pdt = dth[(cc) * 128 + tid]; pdw = dwh[(cc) * 128 + tid]; } } while (0)
        SSD_LOAD(0);
        for (int c = 0; c < 32; ++c) {
            const int t0 = b * SEQ + c * 128;
            LAS float* sAc = (LAS float*)(lds + L_AC); LAS float* sDt = sAc + 128; LAS float* sDw = (LAS float*)(lds + L_XW + 64 * SROW);
            __syncthreads();
#pragma unroll
            for (int i = 0; i < 4; ++i) { const int piece = tid + 512 * i, row = piece >> 4, c16 = piece & 15;
                *(LAS u32x4*)(lds + L_B + row * SROW + c16 * 16) = rb[i];
                *(LAS u32x4*)(lds + L_C + row * SROW + c16 * 16) = rc[i];
            }
            if (tid < 128) { sAc[tid] = pac; sDt[tid] = pdt; sDw[tid] = pdw; }
            { float xo[16]; bf16x2_t pr[18];
#pragma unroll
                for (int i = 0; i < 18; ++i) pr[i] = __builtin_bit_cast(bf16x2_t, (unsigned)xraw[i] | ((unsigned)xraw[i + 1] << 16));
#pragma unroll
                for (int k = 0; k < 16; ++k) xo[k] = silu_f(__builtin_amdgcn_fdot2_f32_bf16(w23, pr[k + 2], __builtin_amdgcn_fdot2_f32_bf16(w01, pr[k], cbx, false), false));
                *(LAS u32x4*)(lds + L_XT + lane * SROW + w * 32) = pack8(xo);
                *(LAS u32x4*)(lds + L_XT + lane * SROW + w * 32 + 16) = pack8(xo + 8);
#pragma unroll
                for (int k = 0; k < 16; ++k) xo[k] *= psx[k >> 2][k & 3];
                *(LAS u32x4*)(lds + L_XW + lane * SROW + w * 32) = pack8(xo);
                *(LAS u32x4*)(lds + L_XW + lane * SROW + w * 32 + 16) = pack8(xo + 8); }
            if (c < 31) SSD_LOAD(c + 1);
            __syncthreads();
            const int lr = lane >> 2, pc = (lane & 3) * 16; const int tz = t0 + 16 * lt + lr;
            bf16_t* zp = Z + ((size_t)((b * 32 + c) * 32 + h) * 128 + (16 * lt + lr)) * 64 + pc;
            const u32x4 z0 = *(const u32x4*)zp, z1 = *(const u32x4*)(zp + 8);
            const float aend = sAc[127];
            const float al = sAc[16 * lt + r16];
            bf16x8 cf[4];
#pragma unroll
            for (int ks = 0; ks < 4; ++ks) cf[ks] = *(const LAS bf16x8*)(lds + L_C + (16 * lt + r16) * SROW + (32 * ks + 8 * q) * 2);
            f32x4 yT[4];
#pragma unroll
            for (int pt = 0; pt < 4; ++pt) { yT[pt] = (f32x4){0.f, 0.f, 0.f, 0.f};
#pragma unroll
                for (int ks = 0; ks < 4; ++ks) { const bf16x8 a = *(const LAS bf16x8*)(lds + L_ST + (c & 1) * (64 * SROW) + (16 * pt + r16) * SROW + (32 * ks + 8 * q) * 2);
                    yT[pt] = __builtin_amdgcn_mfma_f32_16x16x32_bf16(a, cf[ks], yT[pt], 0, 0, 0); } }
            { const float el = __expf(al);
#pragma unroll
                for (int pt = 0; pt < 4; ++pt) yT[pt] *= el; }
            { const float ee = __expf(aend);
#pragma unroll
                for (int pt = 0; pt < 4; ++pt) stT[pt] *= ee;
#pragma unroll
                for (int ks = 0; ks < 4; ++ks) {
                    const LAS unsigned char* tb = lds + L_B + (32 * ks + 8 * q + ((lane & 15) >> 2)) * SROW + w * 32 + (lane & 3) * 8;
                    const s16x4 t0v = __builtin_amdgcn_ds_read_tr16_b64_v4i16((LAS s16x4*)tb), t1v = __builtin_amdgcn_ds_read_tr16_b64_v4i16((LAS s16x4*)(tb + 4 * SROW));
                    bf16x8 a; a[0] = t0v[0]; a[1] = t0v[1]; a[2] = t0v[2]; a[3] = t0v[3]; a[4] = t1v[0]; a[5] = t1v[1]; a[6] = t1v[2]; a[7] = t1v[3];
#pragma unroll
                    for (int pt = 0; pt < 4; ++pt) { const bf16x8 bx = *(const LAS bf16x8*)(lds + L_XW + (16 * pt + r16) * SROW + (32 * ks + 8 * q) * 2);
                        stT[pt] = __builtin_amdgcn_mfma_f32_16x16x32_bf16(a, bx, stT[pt], 0, 0, 0); } }
#pragma unroll
                for (int pt = 0; pt < 4; ++pt) { u32x2 o; o[0] = cvt_pk_bf16(stT[pt][0], stT[pt][1]); o[1] = cvt_pk_bf16(stT[pt][2], stT[pt][3]);
                    *(LAS u32x2*)(lds + L_ST + ((c + 1) & 1) * (64 * SROW) + (16 * pt + r16) * SROW + (16 * w + 4 * q) * 2) = o; } }
            const int lrow = 16 * lt + r16;
            for (int sp = 0; sp <= (lt >> 1); ++sp) {
                unsigned mfr[4];
#pragma unroll
                for (int hf = 0; hf < 2; ++hf) { const int sb = 32 * sp + 16 * hf; f32x4 cb4 = (f32x4){0.f, 0.f, 0.f, 0.f};
                    if (sb <= 16 * lt + 15) {
#pragma unroll
                        for (int ks = 0; ks < 4; ++ks) { const bf16x8 a = *(const LAS bf16x8*)(lds + L_B + (sb + r16) * SROW + (32 * ks + 8 * q) * 2);
                            cb4 = __builtin_amdgcn_mfma_f32_16x16x32_bf16(a, cf[ks], cb4, 0, 0, 0); }
                        const f32x4 as4 = *(const LAS f32x4*)(sAc + sb + 4 * q), dt4 = *(const LAS f32x4*)(sDt + sb + 4 * q);
                        if (sb < 16 * lt) {
                            const f32x4 dw4 = *(const LAS f32x4*)(sDw + sb + 4 * q); const float et = __expf(al - sAc[sb + 15]);
#pragma unroll
                            for (int r = 0; r < 4; ++r) cb4[r] = cb4[r] * (et * dw4[r]);
                        } else {
#pragma unroll
                            for (int r = 0; r < 4; ++r) { const int s_ = sb + 4 * q + r; cb4[r] = (s_ <= lrow) ? cb4[r] * __expf(al - as4[r]) * dt4[r] : 0.f; if (s_ == lrow) cb4[r] += Dh; }
                        }
                    }
                    mfr[2 * hf] = cvt_pk_bf16(cb4[0], cb4[1]); mfr[2 * hf + 1] = cvt_pk_bf16(cb4[2], cb4[3]); }
                bf16x8 mf; { u32x4 t; t[0] = mfr[0]; t[1] = mfr[1]; t[2] = mfr[2]; t[3] = mfr[3]; mf = __builtin_bit_cast(bf16x8, t); }
#pragma unroll
                for (int pt = 0; pt < 4; ++pt) { const u32x2 x0 = *(const LAS u32x2*)(lds + L_XT + (16 * pt + r16) * SROW + (32 * sp + 4 * q) * 2);
                    const u32x2 x1 = *(const LAS u32x2*)(lds + L_XT + (16 * pt + r16) * SROW + (32 * sp + 16 + 4 * q) * 2);
                    u32x4 t; t[0] = x0[0]; t[1] = x0[1]; t[2] = x1[0]; t[3] = x1[1];
                    yT[pt] = __builtin_amdgcn_mfma_f32_16x16x32_bf16(__builtin_bit_cast(bf16x8, t), mf, yT[pt], 0, 0, 0); }
            }
#pragma unroll
            for (int pt = 0; pt < 4; ++pt) { f32x4 o;
#pragma unroll
                for (int r = 0; r < 4; ++r) o[r] = yT[pt][r];
                *(LAS f32x4*)(lds + L_C + lrow * SROW + (16 * pt + 4 * q) * 4) = o; }
            asm volatile("s_waitcnt lgkmcnt(0)" ::: "memory");
            { float yv[16];
#pragma unroll
                for (int i = 0; i < 4; ++i) { const f32x4 v = *(const LAS f32x4*)(lds + L_C + (16 * lt + lr) * SROW + (pc + 4 * i) * 4); yv[4 * i] = v[0]; yv[4 * i + 1] = v[1]; yv[4 * i + 2] = v[2]; yv[4 * i + 3] = v[3]; }
                float ss = 0.f;
#pragma unroll
                for (int i = 0; i < 8; ++i) { const unsigned zw = i < 4 ? z0[i] : z1[i - 4];
                    yv[2 * i] *= bf_lo(zw); yv[2 * i + 1] *= bf_hi(zw); ss += yv[2 * i] * yv[2 * i] + yv[2 * i + 1] * yv[2 * i + 1]; }
                bf16_t* yp = zp;
                *(u32x4*)yp = pack8(yv); *(u32x4*)(yp + 8) = pack8(yv + 8);
                ss += __shfl_xor(ss, 1); ss += __shfl_xor(ss, 2);
                if ((lane & 3) == 0) HSQ[(size_t)tz * 32 + h] = ss; }
        }
#undef SSD_LOAD
    }
    __syncthreads();
}

constexpr int AK_ROW = 144, L_AK = 0, L_AV = 448 * AK_ROW, ATT_LDS_END = L_AV + 448 * AK_ROW;
static_assert(ATT_LDS_END <= LDS_BYTES - 16, "attention LDS");
__device__ __forceinline__ void phase_attn(const Params& P, LAS unsigned char* lds, bf16_t* ogdst) {
    unsigned char* ws = P.ws;
    const bf16_t* Kb = (const bf16_t*)(ws + WS_RZ); const bf16_t* VT = (const bf16_t*)(ws + WS_RZ + 64 * MiB); const bf16_t* Qb = (const bf16_t*)(ws + WS_RZ + 128 * MiB);
    const bf16_t* Gb = (const bf16_t*)(ws + WS_RZ + 192 * MiB);
    const int tid = threadIdx.x, w = __builtin_amdgcn_readfirstlane(tid >> 6), lane = tid & 63, h2 = lane >> 5, r32 = lane & 31;
    bf16x8 U[2];
#pragma unroll
    for (int s = 0; s < 2; ++s)
#pragma unroll
        for (int j = 0; j < 8; ++j) { const int key = 16 * s + 8 * (j >> 2) + 4 * h2 + (j & 3); U[s][j] = (key > r32) ? (short)0x3F80 : (short)0; }
    u32x4 tk[7], tv[7];
#define ATT_WIN_LOAD(it_) do { const int _qt0 = (15 - ((it_) >> 7)) * 8, _bh = (it_) & 127; const int _wlo = _qt0 > 6 ? _qt0 - 6 : 0; const int _nk = (_qt0 + 8 - _wlo) * 32; \
        const bf16_t* _Kp = Kb + (size_t)_bh * SEQ * 64 + (size_t)(_wlo * 32) * 64; const bf16_t* _Vp = VT + (size_t)_bh * SEQ * 64 + (size_t)(_wlo * 32) * 64; \
        _Pragma("unroll") for (int i = 0; i < 7; ++i) { const int pc = tid + 512 * i; if (pc < _nk * 8) { tk[i] = *(const u32x4*)(_Kp + (size_t)pc * 8); tv[i] = *(const u32x4*)(_Vp + (size_t)pc * 8); } } } while (0)
    if ((int)blockIdx.x < 128 * 16) ATT_WIN_LOAD((int)blockIdx.x);
    for (int item = blockIdx.x; item < 128 * 16; item += gridDim.x) {
        const int qb = 15 - (item >> 7), bh = item & 127; const int qt0 = qb * 8; const int wlo = qt0 > 6 ? qt0 - 6 : 0; const int nk = (qt0 + 8 - wlo) * 32;
        const bf16_t* Kp = Kb + (size_t)bh * SEQ * 64; const bf16_t* Vp = VT + (size_t)bh * SEQ * 64; const bf16_t* Qp = Qb + (size_t)bh * SEQ * 64;
        const int qt = qt0 + w, q0 = qt * 32;
        bf16x8 qf[4];
#pragma unroll
        for (int ks = 0; ks < 4; ++ks) qf[ks] = *(const bf16x8*)(Qp + (size_t)(q0 + r32) * 64 + 16 * ks + 8 * h2);
        __syncthreads();
        {
#pragma unroll
            for (int i = 0; i < 7; ++i) { const int pc = tid + 512 * i;
                if (pc < nk * 8) { *(LAS u32x4*)(lds + L_AK + (pc >> 3) * AK_ROW + (pc & 7) * 16) = tk[i];
                    *(LAS u32x4*)(lds + L_AV + (pc >> 3) * AK_ROW + (pc & 7) * 16) = tv[i]; } } }
        __syncthreads();
        asm volatile("s_waitcnt vmcnt(0)" ::: "memory");
        if (item + (int)gridDim.x < 128 * 16) ATT_WIN_LOAD(item + (int)gridDim.x);
        f32x16 o0, o1;
#pragma unroll
        for (int i = 0; i < 16; ++i) { o0[i] = 0.f; o1[i] = 0.f; }
        float carry = 0.f;
        for (int kt = qt; kt >= 0; --kt) {
            const int k0 = kt * 32; const bool diag = (kt == qt);
            bf16x8 kf[4], vf[2][2];
            if (kt >= wlo) { const int kl = (kt - wlo) * 32;
#pragma unroll
                for (int ks = 0; ks < 4; ++ks) kf[ks] = *(const LAS bf16x8*)(lds + L_AK + (kl + r32) * AK_ROW + (16 * ks + 8 * h2) * 2);
#pragma unroll
                for (int dt = 0; dt < 2; ++dt)
#pragma unroll
                    for (int s = 0; s < 2; ++s) {
                        const LAS unsigned char* vp = lds + L_AV + (kl + 16 * s + 4 * h2 + ((lane & 15) >> 2)) * AK_ROW + dt * 64 + ((lane >> 4) & 1) * 32 + (lane & 3) * 8;
                        const s16x4 t0v = __builtin_amdgcn_ds_read_tr16_b64_v4i16((LAS s16x4*)vp), t1v = __builtin_amdgcn_ds_read_tr16_b64_v4i16((LAS s16x4*)(vp + 8 * AK_ROW));
                        bf16x8 f; f[0] = t0v[0]; f[1] = t0v[1]; f[2] = t0v[2]; f[3] = t0v[3]; f[4] = t1v[0]; f[5] = t1v[1]; f[6] = t1v[2]; f[7] = t1v[3];
                        vf[dt][s] = f; }
            } else {
#pragma unroll
                for (int ks = 0; ks < 4; ++ks) kf[ks] = *(const bf16x8*)(Kp + (size_t)(k0 + r32) * 64 + 16 * ks + 8 * h2);
#pragma unroll
                for (int dt = 0; dt < 2; ++dt)
#pragma unroll
                    for (int s = 0; s < 2; ++s) { bf16x8 f;
#pragma unroll
                        for (int j = 0; j < 8; ++j) f[j] = (short)Vp[(size_t)(k0 + 16 * s + 8 * (j >> 2) + 4 * h2 + (j & 3)) * 64 + 32 * dt + r32];
                        vf[dt][s] = f; }
            }
            f32x16 S;
#pragma unroll
            for (int i = 0; i < 16; ++i) S[i] = 0.f;
#pragma unroll
            for (int ks = 0; ks < 4; ++ks) S = __builtin_amdgcn_mfma_f32_32x32x16_bf16(kf[ks], qf[ks], S, 0, 0, 0);
            float lk[16];
#pragma unroll
            for (int r = 0; r < 16; ++r) { const float z = S[r]; const float e = __builtin_amdgcn_exp2f(-fabsf(z));
                float v = -(__builtin_amdgcn_fmed3f(z, 0.f, 3.0e38f) + __builtin_amdgcn_logf(1.0f + e));
                if (diag) { const int key = (r & 3) + 8 * (r >> 2) + 4 * h2; v = (key < r32) ? v : 0.f; }
                lk[r] = v; }
            bf16x8 lf[2];
#pragma unroll
            for (int s = 0; s < 2; ++s) { u32x4 t;
#pragma unroll
                for (int i = 0; i < 4; ++i) t[i] = cvt_pk_bf16(lk[8 * s + 2 * i], lk[8 * s + 2 * i + 1]);
                lf[s] = __builtin_bit_cast(bf16x8, t); }
            f32x16 Suf;
#pragma unroll
            for (int i = 0; i < 16; ++i) Suf[i] = 0.f;
            Suf = __builtin_amdgcn_mfma_f32_32x32x16_bf16(U[0], lf[0], Suf, 0, 0, 0);
            Suf = __builtin_amdgcn_mfma_f32_32x32x16_bf16(U[1], lf[1], Suf, 0, 0, 0);
            const float tot = __shfl(Suf[0] + __uint_as_float(cvt_pk_bf16(lk[0], 0.f) << 16), r32);
            float pw[16];
#pragma unroll
            for (int r = 0; r < 16; ++r) { float wv = __builtin_amdgcn_exp2f(S[r] + lk[r] + Suf[r] + carry);
                if (diag) { const int key = (r & 3) + 8 * (r >> 2) + 4 * h2; wv = (key < r32) ? wv : 0.f; }
                pw[r] = wv; }
            bf16x8 pf[2];
#pragma unroll
            for (int s = 0; s < 2; ++s) { u32x4 t;
#pragma unroll
                for (int i = 0; i < 4; ++i) t[i] = cvt_pk_bf16(pw[8 * s + 2 * i], pw[8 * s + 2 * i + 1]);
                pf[s] = __builtin_bit_cast(bf16x8, t); }
            o0 = __builtin_amdgcn_mfma_f32_32x32x16_bf16(vf[0][0], pf[0], o0, 0, 0, 0);
            o0 = __builtin_amdgcn_mfma_f32_32x32x16_bf16(vf[0][1], pf[1], o0, 0, 0, 0);
            o1 = __builtin_amdgcn_mfma_f32_32x32x16_bf16(vf[1][0], pf[0], o1, 0, 0, 0);
            o1 = __builtin_amdgcn_mfma_f32_32x32x16_bf16(vf[1][1], pf[1], o1, 0, 0, 0);
            carry += tot;
            if (__all(carry < -160.0f)) break;
        }
        const int b = bh >> 4, head = bh & 15; const bf16_t* gp = Gb + (size_t)(b * SEQ + q0 + r32) * DM + head * 64; bf16_t* ogp = ogdst + (size_t)(b * SEQ + q0 + r32) * DM + head * 64;
#pragma unroll
        for (int dt = 0; dt < 2; ++dt)
#pragma unroll
            for (int gq = 0; gq < 4; ++gq) { const int d0 = 32 * dt + 8 * gq + 4 * h2; const u32x2 gv = *(const u32x2*)(gp + d0); u32x2 ov;
                const float a0 = dt ? o1[4 * gq] : o0[4 * gq], a1 = dt ? o1[4 * gq + 1] : o0[4 * gq + 1], a2 = dt ? o1[4 * gq + 2] : o0[4 * gq + 2], a3 = dt ? o1[4 * gq + 3] : o0[4 * gq + 3];
                ov[0] = cvt_pk_bf16(a0 * bf_lo(gv[0]), a1 * bf_hi(gv[0])); ov[1] = cvt_pk_bf16(a2 * bf_lo(gv[1]), a3 * bf_hi(gv[1]));
                *(u32x2*)(ogp + d0) = ov; }
    }
    __syncthreads();
}

#define XB_TMO      128
#define XB_XCNT(j)  (256  + 64 * (j))
#define XB_XSUB(j)  (1280 + 64 * (j))
#define XB_XGEN(j)  (2304 + 64 * (j))
#define XB_TOP      3328
#define XB_TOPGEN   3392
#define XCD_BAR_WORDS 3456
#define XB_SPIN_CAP (1u << 22)
__device__ __forceinline__ unsigned xb_ld(unsigned* p)              { return __hip_atomic_load(p, __ATOMIC_RELAXED, __HIP_MEMORY_SCOPE_AGENT); }
__device__ __forceinline__ unsigned xb_add(unsigned* p, unsigned v) { return __hip_atomic_fetch_add(p, v, __ATOMIC_RELAXED, __HIP_MEMORY_SCOPE_AGENT); }
__device__ __forceinline__ unsigned xb_xcc_id() { return (unsigned)__builtin_amdgcn_s_getreg((3 << 11) | 20) & 0xFu; }
#define XB_SPIN(cond, bar) do { unsigned _sp = 0; while (cond) { __builtin_amdgcn_s_sleep(1); \
    if ((++_sp & 255u) == 0u) { if (xb_ld(&(bar)[XB_TMO])) break; if (_sp > XB_SPIN_CAP) { atomicAdd(&(bar)[XB_TMO], 1u); break; } } } } while (0)
struct XcdBarrier { unsigned* bar; unsigned x; volatile LAS unsigned* st; };
__device__ __forceinline__ XcdBarrier xcd_barrier_post(unsigned* bar, volatile LAS unsigned* st) {
    XcdBarrier b; b.bar = bar; b.x = xb_xcc_id(); b.st = st;
    if (threadIdx.x == 0) (void)xb_add(&bar[XB_XCNT(b.x)], 1u);
    return b;
}
__device__ __forceinline__ void xcd_barrier_complete(unsigned* bar, unsigned x, unsigned& nloc, unsigned& nx) {
    const unsigned G = gridDim.x * gridDim.y * gridDim.z;
    unsigned sum, cnt, mine, sp = 0u;
    for (;;) {
        sum = 0u; cnt = 0u; mine = 0u;
#pragma unroll
        for (unsigned j = 0; j < 16; ++j) { const unsigned c = xb_ld(&bar[XB_XCNT(j)]); sum += c; cnt += (c > 0u) ? 1u : 0u; mine = (j == x) ? c : mine; }
        if (sum == G) break;
        __builtin_amdgcn_s_sleep(1);
        if ((++sp & 255u) == 0u) { if (xb_ld(&bar[XB_TMO])) break; if (sp > XB_SPIN_CAP) { atomicAdd(&bar[XB_TMO], 1u); break; } }
    }
    nloc = mine > 0u ? mine : 1u; nx = cnt > 0u ? cnt : 1u;
}
__device__ __forceinline__ void xcd_barrier(const XcdBarrier& b) {
    asm volatile("s_waitcnt vmcnt(0)" ::: "memory");
    __syncthreads();
    if (threadIdx.x == 0) {
        unsigned* bar = b.bar;
        __builtin_amdgcn_s_waitcnt(0);
        unsigned nloc = b.st[0], nx = b.st[1];
        if (nloc == 0u) { xcd_barrier_complete(bar, b.x, nloc, nx); b.st[0] = nloc; b.st[1] = nx; }
        const unsigned old = xb_add(&bar[XB_XSUB(b.x)], 1u);
        const unsigned gen = old / nloc;
        if (old + 1u == (gen + 1u) * nloc) {
            __builtin_amdgcn_fence(__ATOMIC_RELEASE, "agent");
            asm volatile("s_waitcnt vmcnt(0)" ::: "memory");
            const unsigned og = xb_add(&bar[XB_TOP], 1u);
            const unsigned tg = og / nx;
            if (og + 1u == (tg + 1u) * nx) xb_add(&bar[XB_TOPGEN], 1u);
            else XB_SPIN(xb_ld(&bar[XB_TOPGEN]) == tg, bar);
            __builtin_amdgcn_fence(__ATOMIC_ACQUIRE, "agent");
            xb_add(&bar[XB_XGEN(b.x)], 1u);
            asm volatile("s_waitcnt vmcnt(0)" ::: "memory");
        } else {
            XB_SPIN(xb_ld(&bar[XB_XGEN(b.x)]) == gen, bar);
            __builtin_amdgcn_fence(__ATOMIC_ACQUIRE, "agent");
            asm volatile("s_waitcnt vmcnt(0)" ::: "memory");
        }
    }
    __syncthreads();
}

constexpr int NPHASE = 11;
__global__ void __launch_bounds__(NTHREADS, 2) fwd_megakernel(Params P) {
    extern __shared__ __attribute__((aligned(16))) unsigned char lds_raw[];
    LAS unsigned char* lds = (LAS unsigned char*)lds_raw;
    cg::grid_group grid = cg::this_grid();
    if (P.ph_lo < 0) grid.sync();
    unsigned char* ws = P.ws;
    const int G = gridDim.x, c = blockIdx.x;
    bf16_t* Z = (bf16_t*)(ws + WS_RZ);
    float* ST = (float*)(ws + WS_ST); float* ST2 = (float*)(ws + WS_ST2);
    volatile LAS unsigned* xst = (volatile LAS unsigned*)(lds + LDS_BYTES - 16);
    if (threadIdx.x == 0) { xst[0] = 0u; xst[1] = 0u; }
    __syncthreads();
    XcdBarrier xbar = xcd_barrier_post((unsigned*)(ws + WS_BAR), xst);
#define IN(k) (P.ph_lo <= (k) && (k) < P.ph_hi)
#define SEAM(k) do { if (IN((k) + 1)) xcd_barrier(xbar); } while (0)
    if (IN(0)) {
        phase_prep(P);
        SEAM(0); }
    if (IN(1)) {
        phase_dt(P);
        pg8::Gemm g{(const bf16_t*)(ws + WS_RA), (const bf16_t*)(ws + WS_W1T), T_TOK, ZW, 1024, 1024}; pg8::StaticOrder S; S.init(T_TOK, ZW, G, c);
        EpiZ E{Z, (bf16_t*)(ws + WS_RZ + RZ_XR), (bf16_t*)(ws + WS_RZ + RZ_BCR)};
        pg8::gemm_phase(lds, g, S, E); SEAM(1); }
    if (IN(2)) {
        phase_conv(P);
        SEAM(2); }
    if (IN(3)) {
        phase_ssd(P, lds);
        SEAM(3); }
    if (IN(5)) {
        pg8::Gemm g{Z, (const bf16_t*)(ws + WS_W2T), T_TOK, 1024, 2048, 64}; pg8::StaticOrder S; S.init(T_TOK, 1024, G, c);
        EpiH<true, false, false, true> E{(const float*)(ws + WS_HSQ), (LAS float*)(lds + pg8::STAGE_BYTES), P.x, nullptr, 0, nullptr, 0, nullptr, nullptr, (bf16_t*)(ws + WS_RZ + RZ_XR), 1024, ST};
        pg8::gemm_phase<EpiH<true, false, false, true>, true>(lds, g, S, E);
        SEAM(5); }
    if (IN(6)) {
        { pg8::Gemm g{(const bf16_t*)(ws + WS_RA), (const bf16_t*)(ws + WS_WP0), T_TOK, 1024, 256, 256}; pg8::StaticOrder S; S.init(T_TOK, 1024, G, c);
          EpiBf E{(bf16_t*)(ws + WS_RZ + 192 * MiB), 1024};
          pg8::gemm_phase(lds, g, S, E); }
        { pg8::Gemm g{(const bf16_t*)(ws + WS_RZ + RZ_XR), (const bf16_t*)(ws + WS_WG0), T_TOK, 1024, 1024, 1024}; pg8::StaticOrder S; S.init(T_TOK, 1024, G, c);
          EpiH<false, true, false> E{nullptr, nullptr, nullptr, (const bf16_t*)(ws + WS_RZ + RZ_XR), 1024, (const bf16_t*)(ws + WS_RZ + 192 * MiB), 1024, ST, nullptr, (bf16_t*)(ws + WS_RB), 1024, ST2};
          pg8::gemm_phase(lds, g, S, E); }
        SEAM(6); }
    if (IN(7)) {
        pg8::Gemm g{(const bf16_t*)(ws + WS_RB), (const bf16_t*)(ws + WS_WKVQG), T_TOK, 4096, 1024, 1024}; pg8::StaticOrder S; S.init(T_TOK, 4096, G, c);
        EpiKvqg E{ST2, Z, (bf16_t*)(ws + WS_RZ + 64 * MiB), (bf16_t*)(ws + WS_RZ + 128 * MiB), (bf16_t*)(ws + WS_RZ + 192 * MiB), P.k_norm, P.q_norm};
        pg8::gemm_phase(lds, g, S, E);
        SEAM(7); }
    if (IN(8)) {
        phase_attn(P, lds, (bf16_t*)(ws + WS_RZ + 192 * MiB));
        SEAM(8); }
    if (IN(9)) {
        pg8::Gemm g{(const bf16_t*)(ws + WS_RZ + 192 * MiB), (const bf16_t*)(ws + WS_WSO), T_TOK, 1024, 1024, 1024}; pg8::StaticOrder S; S.init(T_TOK, 1024, G, c);
        EpiH<false, false, false> E{nullptr, nullptr, nullptr, (const bf16_t*)(ws + WS_RB), 1024, nullptr, 0, nullptr, nullptr, (bf16_t*)(ws + WS_RZ + 256 * MiB), 1024, ST};
        pg8::gemm_phase(lds, g, S, E);
        SEAM(9); }
    if (IN(10)) {
        { pg8::Gemm g{(const bf16_t*)(ws + WS_RA + 16 * MiB), (const bf16_t*)(ws + WS_WP1), T_TOK, 1024, 256, 256}; pg8::StaticOrder S; S.init(T_TOK, 1024, G, c);
          EpiBf E{Z, 1024}; pg8::gemm_phase(lds, g, S, E); }
        { pg8::Gemm g{(const bf16_t*)(ws + WS_RZ + 256 * MiB), (const bf16_t*)(ws + WS_WG1), T_TOK, 1024, 1024, 1024}; pg8::StaticOrder S; S.init(T_TOK, 1024, G, c);
          EpiH<false, true, true> E{nullptr, nullptr, nullptr, (const bf16_t*)(ws + WS_RZ + 256 * MiB), 1024, Z, 1024, ST, P.out, nullptr, 0, nullptr};
          pg8::gemm_phase(lds, g, S, E); }
    }
#undef IN
#undef SEAM
}

extern "C" void kernel_launch(void* const* d_in, const int* in_sizes, int n_in, void* d_out, int out_size, void* d_ws, size_t ws_size, hipStream_t stream) {
    static int grid_blocks = 0;
    if (!grid_blocks) {
        int dev = 0, cus = 0, per_cu = 0;
        (void)hipGetDevice(&dev);
        (void)hipDeviceGetAttribute(&cus, hipDeviceAttributeMultiprocessorCount, dev);
        if (hipFuncSetAttribute((const void*)fwd_megakernel, hipFuncAttributeMaxDynamicSharedMemorySize, LDS_BYTES) != hipSuccess) fprintf(stderr, "hipFuncSetAttribute failed\n");
        if (hipOccupancyMaxActiveBlocksPerMultiprocessor(&per_cu, (const void*)fwd_megakernel, NTHREADS, LDS_BYTES) != hipSuccess || per_cu < 1) { fprintf(stderr, "occupancy query: %d\n", per_cu); per_cu = 1; }
        (void)hipGetLastError();
        grid_blocks = cus * per_cu;
        if (ws_size < WS_END) fprintf(stderr, "workspace too small: %zu < %zu\n", ws_size, (size_t)WS_END);
    }
    Params P{};
    P.x = (const float*)d_in[0]; P.p = (const float*)d_in[1]; P.m_norm = (const float*)d_in[2]; P.m_in = (const float*)d_in[3]; P.m_conv_w = (const float*)d_in[4];
    P.m_conv_b = (const float*)d_in[5]; P.m_dt_bias = (const float*)d_in[6]; P.m_A_log = (const float*)d_in[7]; P.m_D = (const float*)d_in[8]; P.m_ynorm = (const float*)d_in[9];
    P.m_out = (const float*)d_in[10]; P.kv_norm = (const float*)d_in[11]; P.w_kv = (const float*)d_in[12]; P.k_norm = (const float*)d_in[13]; P.s_norm = (const float*)d_in[14];
    P.s_in = (const float*)d_in[15]; P.q_norm = (const float*)d_in[16]; P.s_out = (const float*)d_in[17]; P.ple_norm = (const float*)d_in[18]; P.ple_gate = (const float*)d_in[19];
    P.ple_proj = (const float*)d_in[20];
    P.out = (float*)d_out; P.ws = (unsigned char*)d_ws; P.ph_lo = 0; P.ph_hi = NPHASE;
    (void)hipMemsetAsync((char*)d_ws + WS_BAR, 0, 16384, stream);
    void* args[] = {&P};
    hipError_t e = hipLaunchCooperativeKernel((const void*)fwd_megakernel, dim3(grid_blocks), dim3(NTHREADS), args, LDS_BYTES, stream);
    if (e != hipSuccess) fprintf(stderr, "cooperative launch failed: %s (grid %d)\n", hipGetErrorString(e), grid_blocks);
}
```

```cpp
#include <hip/hip_runtime.h>
#include <hip/hip_cooperative_groups.h>
#include <cstdio>
namespace cg = cooperative_groups;

#define LAS __attribute__((address_space(3)))
typedef unsigned short bf16_t;
typedef short bf16x8 __attribute__((ext_vector_type(8)));
typedef float f32x4 __attribute__((ext_vector_type(4)));
typedef float f32x16 __attribute__((ext_vector_type(16)));
typedef unsigned u32x4 __attribute__((ext_vector_type(4)));
typedef unsigned u32x2 __attribute__((ext_vector_type(2)));
typedef short s16x4 __attribute__((ext_vector_type(4)));

constexpr int T_TOK = 32768, DM = 1024, SEQ = 4096, NBATCH = 8;
constexpr int DI = 2048, NHS = 32, NIN = 5152, CONVD = 3072;
constexpr int ZW = 5120;
constexpr int N1P = 5376;
constexpr float EPS = 1e-6f;
constexpr int NTHREADS = 512;

constexpr size_t MiB = 1ull << 20;
constexpr size_t WS_W1T = 0;
constexpr size_t WS_W2T = WS_W1T + (size_t)N1P * 1024 * 2;
constexpr size_t WS_WG0 = WS_W2T + 4 * MiB;
constexpr size_t WS_WG1 = WS_WG0 + 2 * MiB;
constexpr size_t WS_WP0 = WS_WG1 + 2 * MiB;
constexpr size_t WS_WP1 = WS_WP0 + MiB / 2;
constexpr size_t WS_WKVQG = WS_WP1 + MiB / 2;
constexpr size_t WS_WSO = WS_WKVQG + 8 * MiB;
constexpr size_t WS_RA = 30 * MiB;
constexpr size_t WS_RB = WS_RA + 64 * MiB;
constexpr size_t WS_RZ = WS_RB + 64 * MiB;
constexpr size_t WS_DT = WS_RZ + 320 * MiB;
constexpr size_t WS_HSQ = WS_DT + 4 * MiB;
constexpr size_t WS_ST = WS_HSQ + 4 * MiB;
constexpr size_t WS_ST2 = WS_ST + 2 * MiB;
constexpr size_t WS_BAR = WS_ST2 + 2 * MiB;
constexpr size_t WS_ACH = WS_BAR + 16384;
constexpr size_t WS_DTH = WS_ACH + 4 * MiB;
constexpr size_t WS_SCH = WS_DTH + 4 * MiB;
constexpr size_t WS_DWH = WS_SCH + 4 * MiB;
constexpr size_t WS_END = WS_DWH + 4 * MiB;
static_assert(WS_WSO + 2 * MiB <= WS_RA, "weights overflow");
static_assert(WS_END <= 512 * MiB, "workspace overflow");

struct Params {
    const float* x; const float* p; const float* m_norm; const float* m_in; const float* m_conv_w; const float* m_conv_b;
    const float* m_dt_bias; const float* m_A_log; const float* m_D; const float* m_ynorm; const float* m_out;
    const float* kv_norm; const float* w_kv; const float* k_norm; const float* s_norm; const float* s_in; const float* q_norm;
    const float* s_out; const float* ple_norm; const float* ple_gate; const float* ple_proj;
    float* out; unsigned char* ws; int ph_lo, ph_hi;
};

typedef __bf16 bf16x2_t __attribute__((ext_vector_type(2)));
typedef float f32x2_t __attribute__((ext_vector_type(2)));
__device__ __forceinline__ unsigned cvt_pk_bf16(float lo, float hi) { f32x2_t v = {lo, hi}; bf16x2_t b = __builtin_convertvector(v, bf16x2_t); return __builtin_bit_cast(unsigned, b); }
__device__ __forceinline__ float bf_lo(unsigned u) { return __uint_as_float(u << 16); }
__device__ __forceinline__ float bf_hi(unsigned u) { return __uint_as_float(u & 0xffff0000u); }
__device__ __forceinline__ float bf2f(bf16_t b) { return __uint_as_float(((unsigned)b) << 16); }
__device__ __forceinline__ float silu_f(float v) { return v * __builtin_amdgcn_rcpf(1.0f + __expf(-v)); }
__device__ __forceinline__ float sigmoid_f(float v) { return __builtin_amdgcn_rcpf(1.0f + __expf(-v)); }
__device__ __forceinline__ u32x4 pack8(const float* v) { u32x4 r; r[0] = cvt_pk_bf16(v[0], v[1]); r[1] = cvt_pk_bf16(v[2], v[3]); r[2] = cvt_pk_bf16(v[4], v[5]); r[3] = cvt_pk_bf16(v[6], v[7]); return r; }

namespace pg8 {
constexpr int BM = 256, BK = 64, HALF = 128, HTB = HALF * BK * 2, STAGE_BYTES = 8 * HTB, NXCD = 8, WGM = 8;
__device__ __forceinline__ int lds_byte(int r, int c) { const int st = (r >> 4) * 2 + (c >> 5), rr = r & 15, cc = c & 31, ob = rr * 64 + cc * 2; return st * 1024 + (ob ^ (((ob >> 9) & 1) << 5)); }
__device__ __forceinline__ void stage_rc(int b, int& R, int& C) { const int st = b / 1024, sb = b % 1024, swz = sb ^ (((sb >> 9) & 1) << 5); R = (st >> 1) * 16 + swz / 64; C = (st & 1) * 32 + (swz % 64) / 2; }
__device__ __forceinline__ int perm32(int rho) { const int n = rho >> 4, i = rho & 15; return 8 * (i >> 2) + 4 * n + (i & 3); }
struct Unit { int pm, pn; };
struct Gemm { const bf16_t* A; const bf16_t* Bt; int M, N, K, lda; };
struct StaticOrder {
    int nM, nN, nwg, G, c;
    __device__ void init(int M, int N, int G_, int c_) { nM = M / BM; nN = N / BM; nwg = nM * nN; G = G_; c = c_; }
    __device__ bool next(int i, Unit& u) const {
        const long L = (long)i * G + c; if (L >= nwg) return false;
        int wgid = (int)L; { const int q = nwg / NXCD, r = nwg % NXCD, xcd = wgid % NXCD, off = wgid / NXCD; wgid = (xcd < r ? xcd * (q + 1) : r * (q + 1) + (xcd - r) * q) + off; }
        const int nig = WGM * nN, gid = wgid / nig, fm = gid * WGM, gsz = (nM - fm) < WGM ? (nM - fm) : WGM;
        u.pm = fm + ((wgid % nig) % gsz); u.pn = (wgid % nig) / gsz; return true;
    }
};
template <class Epi, bool TILEDA = false>
__device__ __forceinline__ void gemm_phase(LAS unsigned char* lds, const Gemm g, const StaticOrder& S, const Epi& E) {
    typename Epi::KState kst;
    const int tid = threadIdx.x, wid = __builtin_amdgcn_readfirstlane(tid >> 6), lane = tid & 63, wr = wid >> 2, wc = wid & 3, fr = lane & 15, fq = lane >> 4;
    const int K = g.K, nt = K / BK, lda = g.lda;
    unsigned voffA[2], voffB[2];
#pragma unroll
    for (int i = 0; i < 2; ++i) { int R, C; stage_rc(tid * 16 + i * 8192, R, C); const int Rb = (R & ~31) + perm32(R & 31);
        voffA[i] = (unsigned)(R * lda + C) * 2u; voffB[i] = (unsigned)(Rb * K + C) * 2u; }
    const size_t kstep = (size_t)(BK * 2), kstepA = TILEDA ? (size_t)(128 * 64 * 2) : (size_t)(BK * 2);
    const size_t hstepA = TILEDA ? (size_t)(32 * 128 * 64 * 2) : (size_t)HALF * lda * 2, hstepB = (size_t)HALF * K * 2;
    const size_t tstepA = 2 * hstepA, tstepB = 2 * hstepB;
    const unsigned ldsw = (unsigned)wid * 1024u;
    const int aoff = lds_byte(wr * 64 + fr, fq * 8), boff = lds_byte(wc * 32 + fr, fq * 8);
#define PG8_SA(b, h) (((b) * 2 + (h)) * HTB)
#define PG8_SB(b, h) ((4 + (b) * 2 + (h)) * HTB)
#define PG8_STAGE(bufoff, gbase, voff) do { _Pragma("unroll") for (int _i = 0; _i < 2; ++_i) \
        __builtin_amdgcn_global_load_lds((const unsigned*)((const char*)(gbase) + (voff)[_i]), (LAS unsigned*)(lds + (bufoff) + ldsw + _i * 8192), 16, 0, 0); } while (0)
#define PG8_LDA(dst, b, h) do { _Pragma("unroll") for (int m = 0; m < 4; ++m) _Pragma("unroll") for (int k = 0; k < 2; ++k) dst[m][k] = *(const LAS bf16x8*)(lds + PG8_SA(b, h) + aoff + m * 2048 + k * 1024); } while (0)
#define PG8_LDB(dst, b, h) do { _Pragma("unroll") for (int n = 0; n < 2; ++n) _Pragma("unroll") for (int k = 0; k < 2; ++k) dst[n][k] = *(const LAS bf16x8*)(lds + PG8_SB(b, h) + boff + n * 2048 + k * 1024); } while (0)
#define PG8_MMA(ai, bj, At, Bt) do { __builtin_amdgcn_s_setprio(1); _Pragma("unroll") for (int m = 0; m < 4; ++m) _Pragma("unroll") for (int n = 0; n < 2; ++n) _Pragma("unroll") for (int k = 0; k < 2; ++k) \
        acc[ai][bj][m][n] = __builtin_amdgcn_mfma_f32_16x16x32_bf16(Bt[n][k], At[m][k], acc[ai][bj][m][n], 0, 0, 0); __builtin_amdgcn_s_setprio(0); } while (0)
#define PG8_WAIT_V(n) asm volatile("s_waitcnt vmcnt(" #n ")" ::: "memory")
#define PG8_WAIT_L(n) asm volatile("s_waitcnt lgkmcnt(" #n ")" ::: "memory")
#define PG8_BAR __builtin_amdgcn_s_barrier()
#define PG8_SCHED __builtin_amdgcn_sched_barrier(0)
    Unit cur, nxt; int ui = 0;
    if (!S.next(0, cur)) return;
    f32x4 acc[2][2][4][2];
#pragma unroll
    for (int a = 0; a < 2; ++a)
#pragma unroll
        for (int b = 0; b < 2; ++b)
#pragma unroll
            for (int m = 0; m < 4; ++m)
#pragma unroll
                for (int n = 0; n < 2; ++n) acc[a][b][m][n] = (f32x4){0.f, 0.f, 0.f, 0.f};
    bf16x8 At[4][2], B0[2][2], B1[2][2];
    const char* cA = (const char*)g.A + (size_t)cur.pm * tstepA; const char* cB = (const char*)g.Bt + (size_t)cur.pn * tstepB;
    PG8_STAGE(PG8_SB(0, 0), cB, voffB); PG8_STAGE(PG8_SA(0, 0), cA, voffA); PG8_STAGE(PG8_SB(0, 1), cB + hstepB, voffB); PG8_STAGE(PG8_SA(0, 1), cA + hstepA, voffA);
    if (wr == 1) PG8_BAR;
    PG8_WAIT_V(4); PG8_BAR;
    PG8_STAGE(PG8_SB(1, 0), cB + kstep, voffB); PG8_STAGE(PG8_SA(1, 0), cA + kstepA, voffA); PG8_STAGE(PG8_SB(1, 1), cB + hstepB + kstep, voffB);
    PG8_WAIT_V(6); PG8_BAR;
    for (;;) {
        const bool has_next = S.next(ui + 1, nxt);
        const char* nA = has_next ? (const char*)g.A + (size_t)nxt.pm * tstepA : cA; const char* nB = has_next ? (const char*)g.Bt + (size_t)nxt.pn * tstepB : cB;
        E.kbegin(kst, cur, wr, fr, fq);
        for (int t = 0; t < nt; t += 2) {
            const bool last = (t == nt - 2);
            E.kstep(kst, t, acc);
            const char* a1 = cA + (size_t)(t + 1) * kstepA;
            const char* a2 = last ? nA : cA + (size_t)(t + 2) * kstepA; const char* b2 = last ? nB : cB + (size_t)(t + 2) * kstep;
            const char* a3 = a2 + kstepA; const char* b3 = b2 + kstep;
            PG8_LDB(B0, 0, 0); PG8_SCHED; PG8_LDA(At, 0, 0); PG8_STAGE(PG8_SA(1, 1), a1 + hstepA, voffA);
            PG8_WAIT_L(8); PG8_BAR; PG8_WAIT_L(0); PG8_MMA(0, 0, At, B0); PG8_BAR; PG8_SCHED;
            PG8_LDB(B1, 0, 1); PG8_STAGE(PG8_SB(0, 0), b2, voffB);
            PG8_BAR; PG8_WAIT_L(0); PG8_MMA(0, 1, At, B1); PG8_BAR;
            PG8_LDA(At, 0, 1); PG8_STAGE(PG8_SA(0, 0), a2, voffA);
            PG8_BAR; PG8_WAIT_L(0); PG8_MMA(1, 0, At, B0); PG8_BAR; PG8_SCHED;
            PG8_STAGE(PG8_SB(0, 1), b2 + hstepB, voffB);
            PG8_WAIT_V(6); PG8_BAR; PG8_MMA(1, 1, At, B1); PG8_BAR;
            PG8_LDB(B0, 1, 0); PG8_SCHED; PG8_LDA(At, 1, 0); PG8_STAGE(PG8_SA(0, 1), a2 + hstepA, voffA);
            PG8_WAIT_L(8); PG8_BAR; PG8_WAIT_L(0); PG8_MMA(0, 0, At, B0); PG8_BAR; PG8_SCHED;
            PG8_LDB(B1, 1, 1); PG8_STAGE(PG8_SB(1, 0), b3, voffB);
            PG8_BAR; PG8_WAIT_L(0); PG8_MMA(0, 1, At, B1); PG8_BAR;
            PG8_LDA(At, 1, 1); PG8_STAGE(PG8_SA(1, 0), a3, voffA);
            PG8_BAR; PG8_WAIT_L(0); PG8_MMA(1, 0, At, B0); PG8_BAR; PG8_SCHED;
            PG8_STAGE(PG8_SB(1, 1), b3 + hstepB, voffB);
            PG8_WAIT_V(6); PG8_BAR; PG8_MMA(1, 1, At, B1); PG8_BAR;
        }
        E(acc, cur, wr, wc, fr, fq, kst);
        if (!has_next) break;
#pragma unroll
        for (int a = 0; a < 2; ++a)
#pragma unroll
            for (int b = 0; b < 2; ++b)
#pragma unroll
                for (int m = 0; m < 4; ++m)
#pragma unroll
                    for (int n = 0; n < 2; ++n) acc[a][b][m][n] = (f32x4){0.f, 0.f, 0.f, 0.f};
        cur = nxt; cA = nA; cB = nB; ++ui;
    }
    PG8_WAIT_V(0);
    if (wr == 0) PG8_BAR;
    PG8_BAR;
#undef PG8_SA
#undef PG8_SB
#undef PG8_STAGE
#undef PG8_LDA
#undef PG8_LDB
#undef PG8_MMA
#undef PG8_WAIT_V
#undef PG8_WAIT_L
#undef PG8_BAR
#undef PG8_SCHED
}
}
typedef f32x4 AccT[2][2][4][2];

constexpr size_t RZ_XR = 128 * MiB, RZ_BCR = 256 * MiB;
struct EpiZ {
    struct KState {}; __device__ __forceinline__ void kbegin(KState&, const pg8::Unit&, int, int, int) const {} __device__ __forceinline__ void kstep(KState&, int, AccT&) const {}
    bf16_t* ZT; bf16_t* XR; bf16_t* BCR;
    __device__ __forceinline__ void operator()(const AccT& acc, const pg8::Unit& u, int wr, int wc, int fr, int fq, const KState&) const {
        const int row0 = u.pm * 256 + wr * 64 + fr; const bool act = u.pn < 8;
        if (u.pn < 16) {
            bf16_t* base = act ? ZT : XR; const int hc = (u.pn & 7) * 256 + wc * 32 + 8 * fq;
#pragma unroll
            for (int ai = 0; ai < 2; ++ai)
#pragma unroll
                for (int m = 0; m < 4; ++m) { const int row = row0 + ai * 128 + m * 16;
#pragma unroll
                    for (int bj = 0; bj < 2; ++bj) { f32x4 v0 = acc[ai][bj][m][0], v1 = acc[ai][bj][m][1]; const int c = hc + bj * 128;
                        if (act) {
#pragma unroll
                            for (int j = 0; j < 4; ++j) { v0[j] = silu_f(v0[j]); v1[j] = silu_f(v1[j]); } }
                        u32x4 o; o[0] = cvt_pk_bf16(v0[0], v0[1]); o[1] = cvt_pk_bf16(v0[2], v0[3]); o[2] = cvt_pk_bf16(v1[0], v1[1]); o[3] = cvt_pk_bf16(v1[2], v1[3]);
                        *(u32x4*)(base + ((size_t)((row >> 7) * 32 + (c >> 6)) * 128 + (row & 127)) * 64 + (c & 63)) = o; } }
        } else {
            const int c0 = (u.pn - 16) * 256 + wc * 32 + 8 * fq;
#pragma unroll
            for (int ai = 0; ai < 2; ++ai)
#pragma unroll
                for (int m = 0; m < 4; ++m) { bf16_t* rowp = BCR + (size_t)(row0 + ai * 128 + m * 16) * 1024 + c0;
#pragma unroll
                    for (int bj = 0; bj < 2; ++bj) { const f32x4 v0 = acc[ai][bj][m][0], v1 = acc[ai][bj][m][1];
                        u32x4 o; o[0] = cvt_pk_bf16(v0[0], v0[1]); o[1] = cvt_pk_bf16(v0[2], v0[3]); o[2] = cvt_pk_bf16(v1[0], v1[1]); o[3] = cvt_pk_bf16(v1[2], v1[3]);
                        *(u32x4*)(rowp + bj * 128) = o; } }
        }
    }
};
struct EpiBf {
    struct KState {}; __device__ __forceinline__ void kbegin(KState&, const pg8::Unit&, int, int, int) const {} __device__ __forceinline__ void kstep(KState&, int, AccT&) const {}
    bf16_t* O; int ldo;
    __device__ __forceinline__ void operator()(const AccT& acc, const pg8::Unit& u, int wr, int wc, int fr, int fq, const KState&) const {
        const int row0 = u.pm * 256 + wr * 64 + fr, col0 = u.pn * 256 + wc * 32 + 8 * fq;
#pragma unroll
        for (int ai = 0; ai < 2; ++ai)
#pragma unroll
            for (int m = 0; m < 4; ++m) { bf16_t* rowp = O + (size_t)(row0 + ai * 128 + m * 16) * ldo + col0;
#pragma unroll
                for (int bj = 0; bj < 2; ++bj) { const f32x4 v0 = acc[ai][bj][m][0], v1 = acc[ai][bj][m][1];
                    u32x4 o; o[0] = cvt_pk_bf16(v0[0], v0[1]); o[1] = cvt_pk_bf16(v0[2], v0[3]); o[2] = cvt_pk_bf16(v1[0], v1[1]); o[3] = cvt_pk_bf16(v1[2], v1[3]);
                    *(u32x4*)(rowp + bj * 128) = o; } }
    }
};
__device__ __forceinline__ void rows_rstd(const float* st, int row0, int fq, float (&rs)[8]) {
    f32x4 sv[8];
#pragma unroll
    for (int i = 0; i < 8; ++i) sv[i] = *(const f32x4*)(st + (size_t)(row0 + (i >> 2) * 128 + (i & 3) * 16) * 16 + 4 * fq);
#pragma unroll
    for (int i = 0; i < 8; ++i) { float t = (sv[i][0] + sv[i][1]) + (sv[i][2] + sv[i][3]); t += __shfl_xor(t, 16); t += __shfl_xor(t, 32); rs[i] = rsqrtf(t * (1.0f / DM) + EPS); }
}
template <bool RES_F32, bool PLE, bool OUT_F32, bool GNORM = false>
struct EpiH {
    struct KState {};
    const float* hsq; LAS float* rtab;
    __device__ __forceinline__ void kbegin(KState&, const pg8::Unit& u, int wr, int fr, int fq) const {
        if (GNORM) { const int row0 = u.pm * 256 + wr * 64 + fr; LAS float* tb = rtab + (threadIdx.x >> 6) * 512 + (threadIdx.x & 63);
#pragma unroll
            for (int hlf = 0; hlf < 2; ++hlf) { f32x4 a[4], b[4];
#pragma unroll
                for (int i = 0; i < 4; ++i) { const size_t row = (size_t)(row0 + hlf * 128 + i * 16); a[i] = *(const f32x4*)(hsq + row * 32 + 8 * fq); b[i] = *(const f32x4*)(hsq + row * 32 + 8 * fq + 4); }
#pragma unroll
                for (int i = 0; i < 4; ++i) tb[(hlf * 4 + i) * 64] = rsqrtf(((a[i][0] + a[i][1] + a[i][2] + a[i][3]) + (b[i][0] + b[i][1] + b[i][2] + b[i][3])) * (1.0f / 512.0f) + EPS); } }
    }
    __device__ __forceinline__ void kstep(KState&, int t, AccT& acc) const {
        if (GNORM) { if (t == 8 || t == 16 || t == 24) { const int gdone = (t >> 3) - 1; const int fr = threadIdx.x & 15;
            const LAS float* tb = rtab + (threadIdx.x >> 6) * 512 + fr + 16 * gdone;
#pragma unroll
                for (int i = 0; i < 8; ++i) { const float rg = tb[i * 64], rn = tb[i * 64 + 16]; const float f = rg * __builtin_amdgcn_rcpf(rn);
                    const int ai = i >> 2, m = i & 3;
#pragma unroll
                    for (int bj = 0; bj < 2; ++bj)
#pragma unroll
                        for (int n = 0; n < 2; ++n) acc[ai][bj][m][n] *= f; } } }
    }
    const float* res32; const bf16_t* resb; int ldres;
    const bf16_t* pp; int ldpp; const float* st_in;
    float* out32; bf16_t* hb; int ldhb; float* st_out;
    __device__ __forceinline__ void operator()(const AccT& acc, const pg8::Unit& u, int wr, int wc, int fr, int fq, const KState& kst) const {
        const int row0 = u.pm * 256 + wr * 64 + fr, col0 = u.pn * 256 + wc * 32 + 8 * fq;
        float rs[8];
        if (PLE) rows_rstd(st_in, row0, fq, rs);
        if (GNORM) { const LAS float* tb = rtab + (threadIdx.x >> 6) * 512 + fr + 48;
#pragma unroll
            for (int i = 0; i < 8; ++i) rs[i] = tb[i * 64]; }
#pragma unroll
        for (int g2 = 0; g2 < 4; ++g2) { const int ai = g2 >> 1, mb = (g2 & 1) * 2;
            f32x4 rf[2][2][2]; u32x4 rbv[2][2]; u32x4 pv[2][2];
#pragma unroll
            for (int mm = 0; mm < 2; ++mm) { const int row = row0 + ai * 128 + (mb + mm) * 16;
#pragma unroll
                for (int bj = 0; bj < 2; ++bj) {
                    if (RES_F32) { const float* rp = res32 + (size_t)row * DM + col0 + bj * 128; rf[mm][bj][0] = *(const f32x4*)rp; rf[mm][bj][1] = *(const f32x4*)(rp + 4); }
                    else rbv[mm][bj] = *(const u32x4*)(resb + (size_t)row * ldres + col0 + bj * 128);
                    if (PLE) pv[mm][bj] = *(const u32x4*)(pp + (size_t)row * ldpp + col0 + bj * 128); } }
#pragma unroll
            for (int mm = 0; mm < 2; ++mm) { const int m = mb + mm; const int row = row0 + ai * 128 + m * 16; float ss = 0.f;
#pragma unroll
                for (int bj = 0; bj < 2; ++bj) { float v[8], r[8];
                    if (RES_F32) {
#pragma unroll
                        for (int e = 0; e < 4; ++e) { r[e] = rf[mm][bj][0][e]; r[4 + e] = rf[mm][bj][1][e]; } }
                    else {
#pragma unroll
                        for (int e = 0; e < 4; ++e) { r[2 * e] = bf_lo(rbv[mm][bj][e]); r[2 * e + 1] = bf_hi(rbv[mm][bj][e]); } }
#pragma unroll
                    for (int e = 0; e < 8; ++e) { const float a = acc[ai][bj][m][e >> 2][e & 3];
                        if (PLE) { const unsigned w = pv[mm][bj][e >> 1]; const float pe = (e & 1) ? bf_hi(w) : bf_lo(w); v[e] = r[e] + pe * sigmoid_f(rs[ai * 4 + m] * a); }
                        else v[e] = r[e] + (GNORM ? rs[ai * 4 + m] * a : a);
                        ss += v[e] * v[e]; }
                    if (OUT_F32) { float* op = out32 + (size_t)row * DM + col0 + bj * 128;
                        *(f32x4*)op = (f32x4){v[0], v[1], v[2], v[3]}; *(f32x4*)(op + 4) = (f32x4){v[4], v[5], v[6], v[7]}; }
                    if (hb) *(u32x4*)(hb + (size_t)row * ldhb + col0 + bj * 128) = pack8(v); }
                if (st_out) { ss += __shfl_xor(ss, 16); ss += __shfl_xor(ss, 32);
                    if (fq == 0) st_out[(size_t)row * 16 + u.pn * 4 + wc] = ss; } }
        }
    }
};
struct EpiKvqg {
    struct KState {}; __device__ __forceinline__ void kbegin(KState&, const pg8::Unit&, int, int, int) const {} __device__ __forceinline__ void kstep(KState&, int, AccT&) const {}
    const float* st_in; bf16_t* Kb; bf16_t* VT; bf16_t* Qb; bf16_t* Gb; const float* k_g; const float* q_g;
    __device__ __forceinline__ void operator()(const AccT& acc, const pg8::Unit& u, int wr, int wc, int fr, int fq, const KState&) const {
        const int row0 = u.pm * 256 + wr * 64 + fr; const int sec = u.pn >> 2, head = 4 * (u.pn & 3) + wc;
        float rsv[8]; rows_rstd(st_in, row0, fq, rsv);
        float gnv[2][8];
        if (sec == 0 || sec == 2) { const float* gn = sec == 0 ? k_g : q_g;
#pragma unroll
            for (int bj = 0; bj < 2; ++bj)
#pragma unroll
                for (int e = 0; e < 8; ++e) gnv[bj][e] = gn[32 * bj + 8 * fq + e]; }
#pragma unroll
        for (int ai = 0; ai < 2; ++ai)
#pragma unroll
            for (int m = 0; m < 4; ++m) { const int row = row0 + ai * 128 + m * 16; const float rs = rsv[ai * 4 + m];
                const int b = row >> 12, s = row & 4095;
                float v[2][8];
#pragma unroll
                for (int bj = 0; bj < 2; ++bj)
#pragma unroll
                    for (int n = 0; n < 2; ++n)
#pragma unroll
                        for (int j = 0; j < 4; ++j) v[bj][4 * n + j] = acc[ai][bj][m][n][j] * rs;
                if (sec == 0 || sec == 2) {
                    float ss = 0.f;
#pragma unroll
                    for (int bj = 0; bj < 2; ++bj)
#pragma unroll
                        for (int e = 0; e < 8; ++e) ss += v[bj][e] * v[bj][e];
                    ss += __shfl_xor(ss, 16); ss += __shfl_xor(ss, 32);
                    const float r = rsqrtf(ss * (1.0f / 64.0f) + EPS) * (sec == 2 ? 0.125f * 1.4426950408889634f : 1.0f);
                    bf16_t* dst = (sec == 0 ? Kb : Qb) + ((size_t)(b * 16 + head) * SEQ + s) * 64;
#pragma unroll
                    for (int bj = 0; bj < 2; ++bj) { const int d0 = 32 * bj + 8 * fq; float w[8];
#pragma unroll
                        for (int e = 0; e < 8; ++e) w[e] = v[bj][e] * r * gnv[bj][e];
                        *(u32x4*)(dst + d0) = pack8(w); }
                } else if (sec == 1) {
                    bf16_t* dst = VT + ((size_t)(b * 16 + head) * SEQ + s) * 64;
#pragma unroll
                    for (int bj = 0; bj < 2; ++bj) { const int d0 = 32 * bj + 8 * fq; *(u32x4*)(dst + d0) = pack8(v[bj]); }
                } else {
#pragma unroll
                    for (int bj = 0; bj < 2; ++bj) { const int d0 = 32 * bj + 8 * fq; float w[8];
#pragma unroll
                        for (int e = 0; e < 8; ++e) w[e] = silu_f(v[bj][e]);
                        *(u32x4*)(Gb + (size_t)row * DM + head * 64 + d0) = pack8(w); }
                }
            }
    }
};

template <class F>
__device__ __forceinline__ void wt_cvt(bf16_t* dst, int Ndst, int K, long gtid, long gth, F src) {
    const long items = (long)Ndst * (K / 8);
    for (long i0 = gtid; i0 < items; i0 += 2 * gth) { float v[2][8];
#pragma unroll
        for (int u = 0; u < 2; ++u) { const long i = i0 + u * gth; if (i < items) { const int n = (int)(i % Ndst), k0 = (int)(i / Ndst) * 8;
#pragma unroll
                for (int e = 0; e < 8; ++e) v[u][e] = src(n, k0 + e); } }
#pragma unroll
        for (int u = 0; u < 2; ++u) { const long i = i0 + u * gth; if (i < items) { const int n = (int)(i % Ndst), k0 = (int)(i / Ndst) * 8;
                *(u32x4*)(dst + (size_t)n * K + k0) = pack8(v[u]); } } }
}
__device__ __forceinline__ void phase_prep(const Params& P) {
    unsigned char* ws = P.ws;
    const long gtid = (long)blockIdx.x * NTHREADS + threadIdx.x, gth = (long)gridDim.x * NTHREADS;
    { const float* w = P.m_in; wt_cvt((bf16_t*)(ws + WS_W1T), NIN, 1024, gtid, gth, [=](int n, int k) { return w[(size_t)k * NIN + n]; }); }
    { const float* w = P.m_out; const float* g = P.m_ynorm; wt_cvt((bf16_t*)(ws + WS_W2T), 1024, 2048, gtid, gth, [=](int n, int k) { return w[(size_t)k * 1024 + n] * g[k]; }); }
    for (int i = 0; i < 2; ++i) { const float* w = P.ple_gate + (size_t)i * 1024 * 1024; const float* g = P.ple_norm + i * 1024;
        wt_cvt((bf16_t*)(ws + (i ? WS_WG1 : WS_WG0)), 1024, 1024, gtid, gth, [=](int n, int k) { return w[(size_t)k * 1024 + n] * g[k]; });
        const float* wp = P.ple_proj + (size_t)i * 256 * 1024;
        wt_cvt((bf16_t*)(ws + (i ? WS_WP1 : WS_WP0)), 1024, 256, gtid, gth, [=](int n, int k) { return wp[(size_t)k * 1024 + n]; }); }
    { const float* wkv = P.w_kv; const float* gkv = P.kv_norm; const float* wq = P.s_in; const float* gq = P.s_norm;
        wt_cvt((bf16_t*)(ws + WS_WKVQG), 4096, 1024, gtid, gth, [=](int n, int k) {
            const int pn = n >> 8, cl = n & 255, bj = cl >> 7, wc = (cl >> 5) & 3, i = cl & 31, sec = pn >> 2, head = 4 * (pn & 3) + wc, d = 32 * bj + i;
            const int sc = (sec & 1) * 1024 + head * 64 + d;
            return sec < 2 ? wkv[(size_t)k * 2048 + sc] * gkv[k] : wq[(size_t)k * 2048 + sc] * gq[k]; }); }
    { const float* w = P.s_out; wt_cvt((bf16_t*)(ws + WS_WSO), 1024, 1024, gtid, gth, [=](int n, int k) { return w[(size_t)k * 1024 + n]; }); }
    const int lane = threadIdx.x & 63; const int gw = (int)(gtid >> 6), nw = (int)(gth >> 6);
    bf16_t* u0 = (bf16_t*)(ws + WS_RA);
    f32x4 gm[4];
#pragma unroll
    for (int i = 0; i < 4; ++i) gm[i] = *(const f32x4*)(P.m_norm + i * 256 + lane * 4);
    for (int rowb = gw * 4; rowb < T_TOK; rowb += nw * 4) { f32x4 v[4][4];
#pragma unroll
        for (int r = 0; r < 4; ++r)
#pragma unroll
            for (int i = 0; i < 4; ++i) v[r][i] = *(const f32x4*)(P.x + (size_t)(rowb + r) * DM + i * 256 + lane * 4);
#pragma unroll
        for (int r = 0; r < 4; ++r) { float ss = 0.f;
#pragma unroll
            for (int i = 0; i < 4; ++i) ss += v[r][i][0] * v[r][i][0] + v[r][i][1] * v[r][i][1] + v[r][i][2] * v[r][i][2] + v[r][i][3] * v[r][i][3];
#pragma unroll
            for (int o = 1; o < 64; o <<= 1) ss += __shfl_xor(ss, o);
            const float rs = rsqrtf(ss * (1.0f / DM) + EPS);
#pragma unroll
            for (int i = 0; i < 4; ++i) { u32x2 o;
                o[0] = cvt_pk_bf16(v[r][i][0] * rs * gm[i][0], v[r][i][1] * rs * gm[i][1]); o[1] = cvt_pk_bf16(v[r][i][2] * rs * gm[i][2], v[r][i][3] * rs * gm[i][3]);
                *(u32x2*)(u0 + (size_t)(rowb + r) * DM + i * 256 + lane * 4) = o; } } }
}

__device__ __forceinline__ void phase_dt(const Params& P) {
    const bf16_t* u0 = (const bf16_t*)(P.ws + WS_RA); const bf16_t* Wdt = (const bf16_t*)(P.ws + WS_W1T) + (size_t)5120 * 1024; float* DT = (float*)(P.ws + WS_DT);
    const int tid = threadIdx.x, w = tid >> 6, lane = tid & 63, h2 = lane >> 5, r32 = lane & 31;
    for (int tile = blockIdx.x + gridDim.x * w; tile < T_TOK / 32; tile += gridDim.x * 8) {
        const bf16_t* ap = u0 + (size_t)(tile * 32 + r32) * 1024 + 8 * h2; const bf16_t* bp = Wdt + (size_t)r32 * 1024 + 8 * h2;
        f32x16 acc;
#pragma unroll
        for (int i = 0; i < 16; ++i) acc[i] = 0.f;
#pragma unroll 8
        for (int ks = 0; ks < 64; ++ks) { const bf16x8 a = *(const bf16x8*)(ap + 16 * ks); const bf16x8 bw = *(const bf16x8*)(bp + 16 * ks);
            acc = __builtin_amdgcn_mfma_f32_32x32x16_bf16(a, bw, acc, 0, 0, 0); }
        const float bias = P.m_dt_bias[r32];
#pragma unroll
        for (int r = 0; r < 16; ++r) { const int row = tile * 32 + (r & 3) + 8 * (r >> 2) + 4 * h2; const float xx = acc[r] + bias;
            DT[(size_t)row * 32 + r32] = xx > 20.f ? xx : log1pf(__expf(xx)); }
    }
}

__device__ __forceinline__ void phase_conv(const Params& P) {
    unsigned char* ws = P.ws;
    const long gtid = (long)blockIdx.x * NTHREADS + threadIdx.x, gth = (long)gridDim.x * NTHREADS;
    const bf16_t* BCR = (const bf16_t*)(ws + WS_RZ + RZ_BCR); bf16_t* BC = (bf16_t*)(ws + WS_RB);
    {
      const int cgi = (int)(gtid & 127), ch = 2048 + cgi * 8; const long nitem = (long)(T_TOK / 8) * 128;
      float cw[4][8], cb[8];
#pragma unroll
      for (int j = 0; j < 4; ++j) { const f32x4 a = *(const f32x4*)(P.m_conv_w + j * CONVD + ch), b = *(const f32x4*)(P.m_conv_w + j * CONVD + ch + 4);
#pragma unroll
          for (int e = 0; e < 4; ++e) { cw[j][e] = a[e]; cw[j][4 + e] = b[e]; } }
      { const f32x4 a = *(const f32x4*)(P.m_conv_b + ch), b = *(const f32x4*)(P.m_conv_b + ch + 4);
#pragma unroll
          for (int e = 0; e < 4; ++e) { cb[e] = a[e]; cb[4 + e] = b[e]; } }
      for (long it0 = gtid; it0 < nitem; it0 += 2 * gth) {
        u32x4 raw[2][11];
#pragma unroll
        for (int u = 0; u < 2; ++u) { const long it = it0 + u * gth; if (it < nitem) { const int tg = (int)(it >> 7), t0 = tg * 8, s0 = t0 & 4095;
#pragma unroll
            for (int r = 0; r < 11; ++r) { if (s0 - 3 + r >= 0) raw[u][r] = *(const u32x4*)(BCR + (size_t)(t0 - 3 + r) * 1024 + cgi * 8); else raw[u][r] = (u32x4){0u, 0u, 0u, 0u}; } } }
#pragma unroll
        for (int u = 0; u < 2; ++u) { const long it = it0 + u * gth; if (it < nitem) { const int tg = (int)(it >> 7), t0 = tg * 8;
#pragma unroll
          for (int r = 0; r < 8; ++r) { float o[8];
#pragma unroll
            for (int e = 0; e < 8; ++e) { float a = cb[e];
#pragma unroll
                for (int j = 0; j < 4; ++j) { const unsigned w = raw[u][r + j][e >> 1]; a += cw[j][e] * ((e & 1) ? bf_hi(w) : bf_lo(w)); }
                o[e] = silu_f(a); }
            *(u32x4*)(BC + (size_t)(t0 + r) * 1024 + cgi * 8) = pack8(o); } } }
      } }
    { const float* DTg = (const float*)(ws + WS_DT); float* ACh = (float*)(ws + WS_ACH); float* DTh = (float*)(ws + WS_DTH); float* SCh = (float*)(ws + WS_SCH); float* DWh = (float*)(ws + WS_DWH);
      const int lane = threadIdx.x & 63; const int gw = (int)(gtid >> 6), nw = (int)(gth >> 6);
      for (int it = gw; it < NBATCH * NHS * 32; it += nw) { const int h = it & 31, c = (it >> 5) & 31, b = it >> 10; const int t0 = b * SEQ + c * 128;
        const float Ah = -__expf(P.m_A_log[h]);
        const float d0 = DTg[(size_t)(t0 + lane) * 32 + h], d1 = DTg[(size_t)(t0 + 64 + lane) * 32 + h];
        float a0 = d0 * Ah, a1 = d1 * Ah;
#pragma unroll
        for (int o = 1; o < 64; o <<= 1) { const float t = __shfl_up(a0, o); if (lane >= o) a0 += t; }
#pragma unroll
        for (int o = 1; o < 64; o <<= 1) { const float t = __shfl_up(a1, o); if (lane >= o) a1 += t; }
        a1 += __shfl(a0, 63);
        const float ae = __shfl(a1, 63);
        const size_t o0 = (size_t)(b * 32 + h) * SEQ + c * 128 + lane;
        const float e0 = __shfl(a0, lane | 15), e1 = __shfl(a1, lane | 15);
        ACh[o0] = a0; ACh[o0 + 64] = a1; DTh[o0] = d0; DTh[o0 + 64] = d1; SCh[o0] = d0 * __expf(ae - a0); SCh[o0 + 64] = d1 * __expf(ae - a1);
        DWh[o0] = d0 * __expf(e0 - a0); DWh[o0 + 64] = d1 * __expf(e1 - a1); } }
    bf16_t* pb = (bf16_t*)(ws + WS_RA);
    { const long npb = (long)2 * T_TOK * 256 / 8;
      for (long it0 = gtid; it0 < npb; it0 += 4 * gth) { f32x4 a[4], b[4];
#pragma unroll
        for (int u = 0; u < 4; ++u) { const long it = it0 + u * gth; if (it < npb) { a[u] = *(const f32x4*)(P.p + it * 8); b[u] = *(const f32x4*)(P.p + it * 8 + 4); } }
#pragma unroll
        for (int u = 0; u < 4; ++u) { const long it = it0 + u * gth; if (it < npb) { u32x4 o; o[0] = cvt_pk_bf16(a[u][0], a[u][1]); o[1] = cvt_pk_bf16(a[u][2], a[u][3]); o[2] = cvt_pk_bf16(b[u][0], b[u][1]); o[3] = cvt_pk_bf16(b[u][2], b[u][3]);
            *(u32x4*)(pb + it * 8) = o; } } } }
}

constexpr int SROW = 272;
constexpr int L_B = 0, L_C = 34816, L_XW = 69632  , L_XT = 104448, L_ST = 121856  , L_AC = 156672  , L_SSD_END = 157696;
constexpr int LDS_BYTES = 158720;
static_assert(L_SSD_END <= LDS_BYTES - 16 && pg8::STAGE_BYTES + 16384 <= LDS_BYTES - 16, "LDS");

__device__ __forceinline__ void phase_ssd(const Params& P, LAS unsigned char* lds, bf16_t* ydst, int ldy) {
    unsigned char* ws = P.ws;
    bf16_t* Z = (bf16_t*)(ws + WS_RZ); const bf16_t* BC = (const bf16_t*)(ws + WS_RB);
    const float* ACh = (const float*)(ws + WS_ACH); const float* DTh = (const float*)(ws + WS_DTH); const float* SCh = (const float*)(ws + WS_SCH); const float* DWh = (const float*)(ws + WS_DWH); float* HSQ = (float*)(ws + WS_HSQ);
    const int tid = threadIdx.x, w = __builtin_amdgcn_readfirstlane(tid >> 6), lane = tid & 63, q = lane >> 4, r16 = lane & 15;
    const int lt = w < 4 ? w : 11 - w;
    for (int item = blockIdx.x; item < NBATCH * NHS; item += gridDim.x) {
        const int bg = (item & 7) * 4 + (item >> 6), g = bg & 3, b = bg >> 2, h = g * 8 + ((item >> 3) & 7);
        const float Ah = -__expf(P.m_A_log[h]), Dh = P.m_D[h];
        const bf16_t* XR = (const bf16_t*)(ws + WS_RZ + RZ_XR);
        float cwx[4]; const int xch = h * 64 + lane;
#pragma unroll
        for (int j = 0; j < 4; ++j) cwx[j] = P.m_conv_w[j * CONVD + xch];
        const float cbx = P.m_conv_b[xch];
        const bf16x2_t w01 = __builtin_bit_cast(bf16x2_t, cvt_pk_bf16(cwx[0], cwx[1])), w23 = __builtin_bit_cast(bf16x2_t, cvt_pk_bf16(cwx[2], cwx[3]));
        f32x4 stT[4];
#pragma unroll
        for (int pt = 0; pt < 4; ++pt) stT[pt] = (f32x4){0.f, 0.f, 0.f, 0.f};
        __syncthreads();
        for (int i = tid; i < 2 * 64 * SROW / 4; i += NTHREADS) ((LAS unsigned*)(lds + L_ST))[i] = 0u;
        u32x4 rb[4], rc[4]; bf16_t xraw[19]; float pac = 0.f, pdt = 0.f, pdw = 0.f; f32x4 psx[4];
        const float* ach = ACh + (size_t)(b * 32 + h) * SEQ; const float* dth = DTh + (size_t)(b * 32 + h) * SEQ; const float* sch = SCh + (size_t)(b * 32 + h) * SEQ; const float* dwh = DWh + (size_t)(b * 32 + h) * SEQ;
#define SSD_LOAD(cc) do { const int _t0 = b * SEQ + (cc) * 128; \
            _Pragma("unroll") for (int i = 0; i < 4; ++i) { const int piece = tid + 512 * i, row = piece >> 4, c16 = piece & 15; \
                rb[i] = *(const u32x4*)(BC + (size_t)(_t0 + row) * 1024 + g * 128 + c16 * 8); \
                rc[i] = *(const u32x4*)(BC + (size_t)(_t0 + row) * 1024 + 512 + g * 128 + c16 * 8); \
                } \
            _Pragma("unroll") for (int i = 0; i < 19; ++i) { const int sl = 16 * w - 3 + i; \
                const int tk = (cc) * 128 + sl; if ((cc) == 0 && sl < 0) xraw[i] = 0; else xraw[i] = XR[((size_t)((b * 32 + (tk >> 7)) * 32 + h) * 128 + (tk & 127)) * 64 + lane]; } \
            _Pragma("unroll") for (int i = 0; i < 4; ++i) psx[i] = *(const f32x4*)(sch + (cc) * 128 + 16 * w + 4 * i); \
            if (tid < 128) { pac = ach[(cc) * 128 + tid]; pdt = dth[(cc) * 128 + tid]; pdw = dwh[(cc) * 128 + tid]; } } while (0)
        SSD_LOAD(0);
        for (int c = 0; c < 32; ++c) {
            const int t0 = b * SEQ + c * 128;
            LAS float* sAc = (LAS float*)(lds + L_AC); LAS float* sDt = sAc + 128; LAS float* sDw = (LAS float*)(lds + L_XW + 64 * SROW);
            __syncthreads();
#pragma unroll
            for (int i = 0; i < 4; ++i) { const int piece = tid + 512 * i, row = piece >> 4, c16 = piece & 15;
                *(LAS u32x4*)(lds + L_B + row * SROW + c16 * 16) = rb[i];
                *(LAS u32x4*)(lds + L_C + row * SROW + c16 * 16) = rc[i];
            }
            if (tid < 128) { sAc[tid] = pac; sDt[tid] = pdt; sDw[tid] = pdw; }
            { float xo[16]; bf16x2_t pr[18];
#pragma unroll
                for (int i = 0; i < 18; ++i) pr[i] = __builtin_bit_cast(bf16x2_t, (unsigned)xraw[i] | ((unsigned)xraw[i + 1] << 16));
#pragma unroll
                for (int k = 0; k < 16; ++k) xo[k] = silu_f(__builtin_amdgcn_fdot2_f32_bf16(w23, pr[k + 2], __builtin_amdgcn_fdot2_f32_bf16(w01, pr[k], cbx, false), false));
                *(LAS u32x4*)(lds + L_XT + lane * SROW + w * 32) = pack8(xo);
                *(LAS u32x4*)(lds + L_XT + lane * SROW + w * 32 + 16) = pack8(xo + 8);
#pragma unroll
                for (int k = 0; k < 16; ++k) xo[k] *= psx[k >> 2][k & 3];
                *(LAS u32x4*)(lds + L_XW + lane * SROW + w * 32) = pack8(xo);
                *(LAS u32x4*)(lds + L_XW + lane * SROW + w * 32 + 16) = pack8(xo + 8); }
            if (c < 31) SSD_LOAD(c + 1);
            __syncthreads();
            const int lr = lane >> 2, pc = (lane & 3) * 16; const int tz = t0 + 16 * lt + lr;
            bf16_t* zp = Z + ((size_t)((b * 32 + c) * 32 + h) * 128 + (16 * lt + lr)) * 64 + pc;
            const u32x4 z0 = *(const u32x4*)zp, z1 = *(const u32x4*)(zp + 8);
            const float aend = sAc[127];
            const float al = sAc[16 * lt + r16];
            bf16x8 cf[4];
#pragma unroll
            for (int ks = 0; ks < 4; ++ks) cf[ks] = *(const LAS bf16x8*)(lds + L_C + (16 * lt + r16) * SROW + (32 * ks + 8 * q) * 2);
            f32x4 yT[4];
#pragma unroll
            for (int pt = 0; pt < 4; ++pt) { yT[pt] = (f32x4){0.f, 0.f, 0.f, 0.f};
#pragma unroll
                for (int ks = 0; ks < 4; ++ks) { const bf16x8 a = *(const LAS bf16x8*)(lds + L_ST + (c & 1) * (64 * SROW) + (16 * pt + r16) * SROW + (32 * ks + 8 * q) * 2);
                    yT[pt] = __builtin_amdgcn_mfma_f32_16x16x32_bf16(a, cf[ks], yT[pt], 0, 0, 0); } }
            { const float el = __expf(al);
#pragma unroll
                for (int pt = 0; pt < 4; ++pt) yT[pt] *= el; }
            { const float ee = __expf(aend);
#pragma unroll
                for (int pt = 0; pt < 4; ++pt) stT[pt] *= ee;
#pragma unroll
                for (int ks = 0; ks < 4; ++ks) {
                    const LAS unsigned char* tb = lds + L_B + (32 * ks + 8 * q + ((lane & 15) >> 2)) * SROW + w * 32 + (lane & 3) * 8;
                    const s16x4 t0v = __builtin_amdgcn_ds_read_tr16_b64_v4i16((LAS s16x4*)tb), t1v = __builtin_amdgcn_ds_read_tr16_b64_v4i16((LAS s16x4*)(tb + 4 * SROW));
                    bf16x8 a; a[0] = t0v[0]; a[1] = t0v[1]; a[2] = t0v[2]; a[3] = t0v[3]; a[4] = t1v[0]; a[5] = t1v[1]; a[6] = t1v[2]; a[7] = t1v[3];
#pragma unroll
                    for (int pt = 0; pt < 4; ++pt) { const bf16x8 bx = *(const LAS bf16x8*)(lds + L_XW + (16 * pt + r16) * SROW + (32 * ks + 8 * q) * 2);
                        stT[pt] = __builtin_amdgcn_mfma_f32_16x16x32_bf16(a, bx, stT[pt], 0, 0, 0); } }
#pragma unroll
                for (int pt = 0; pt < 4; ++pt) { u32x2 o; o[0] = cvt_pk_bf16(stT[pt][0], stT[pt][1]); o[1] = cvt_pk_bf16(stT[pt][2], stT[pt][3]);
                    *(LAS u32x2*)(lds + L_ST + ((c + 1) & 1) * (64 * SROW) + (16 * pt + r16) * SROW + (16 * w + 4 * q) * 2) = o; } }
            const int lrow = 16 * lt + r16;
            for (int sp = 0; sp <= (lt >> 1); ++sp) {
                unsigned mfr[4];
#pragma unroll
                for (int hf = 0; hf < 2; ++hf) { const int sb = 32 * sp + 16 * hf; f32x4 cb4 = (f32x4){0.f, 0.f, 0.f, 0.f};
                    if (sb <= 16 * lt + 15) {
#pragma unroll
                        for (int ks = 0; ks < 4; ++ks) { const bf16x8 a = *(const LAS bf16x8*)(lds + L_B + (sb + r16) * SROW + (32 * ks + 8 * q) * 2);
                            cb4 = __builtin_amdgcn_mfma_f32_16x16x32_bf16(a, cf[ks], cb4, 0, 0, 0); }
                        const f32x4 as4 = *(const LAS f32x4*)(sAc + sb + 4 * q), dt4 = *(const LAS f32x4*)(sDt + sb + 4 * q);
                        if (sb < 16 * lt) {
                            const f32x4 dw4 = *(const LAS f32x4*)(sDw + sb + 4 * q); const float et = __expf(al - sAc[sb + 15]);
#pragma unroll
                            for (int r = 0; r < 4; ++r) cb4[r] = cb4[r] * (et * dw4[r]);
                        } else {
#pragma unroll
                            for (int r = 0; r < 4; ++r) { const int s_ = sb + 4 * q + r; cb4[r] = (s_ <= lrow) ? cb4[r] * __expf(al - as4[r]) * dt4[r] : 0.f; if (s_ == lrow) cb4[r] += Dh; }
                        }
                    }
                    mfr[2 * hf] = cvt_pk_bf16(cb4[0], cb4[1]); mfr[2 * hf + 1] = cvt_pk_bf16(cb4[2], cb4[3]); }
                bf16x8 mf; { u32x4 t; t[0] = mfr[0]; t[1] = mfr[1]; t[2] = mfr[2]; t[3] = mfr[3]; mf = __builtin_bit_cast(bf16x8, t); }
#pragma unroll
                for (int pt = 0; pt < 4; ++pt) { const u32x2 x0 = *(const LAS u32x2*)(lds + L_XT + (16 * pt + r16) * SROW + (32 * sp + 4 * q) * 2);
                    const u32x2 x1 = *(const LAS u32x2*)(lds + L_XT + (16 * pt + r16) * SROW + (32 * sp + 16 + 4 * q) * 2);
                    u32x4 t; t[0] = x0[0]; t[1] = x0[1]; t[2] = x1[0]; t[3] = x1[1];
                    yT[pt] = __builtin_amdgcn_mfma_f32_16x16x32_bf16(__builtin_bit_cast(bf16x8, t), mf, yT[pt], 0, 0, 0); }
            }
#pragma unroll
            for (int pt = 0; pt < 4; ++pt) { f32x4 o;
#pragma unroll
                for (int r = 0; r < 4; ++r) o[r] = yT[pt][r];
                *(LAS f32x4*)(lds + L_C + lrow * SROW + (16 * pt + 4 * q) * 4) = o; }
            asm volatile("s_waitcnt lgkmcnt(0)" ::: "memory");
            { float yv[16];
#pragma unroll
                for (int i = 0; i < 4; ++i) { const f32x4 v = *(const LAS f32x4*)(lds + L_C + (16 * lt + lr) * SROW + (pc + 4 * i) * 4); yv[4 * i] = v[0]; yv[4 * i + 1] = v[1]; yv[4 * i + 2] = v[2]; yv[4 * i + 3] = v[3]; }
                float ss = 0.f;
#pragma unroll
                for (int i = 0; i < 8; ++i) { const unsigned zw = i < 4 ? z0[i] : z1[i - 4];
                    yv[2 * i] *= bf_lo(zw); yv[2 * i + 1] *= bf_hi(zw); ss += yv[2 * i] * yv[2 * i] + yv[2 * i + 1] * yv[2 * i + 1]; }
                bf16_t* yp = zp;
                *(u32x4*)yp = pack8(yv); *(u32x4*)(yp + 8) = pack8(yv + 8);
                ss += __shfl_xor(ss, 1); ss += __shfl_xor(ss, 2);
                if ((lane & 3) == 0) HSQ[(size_t)tz * 32 + h] = ss; }
        }
#undef SSD_LOAD
    }
    __syncthreads();
}

constexpr int AK_ROW = 144, L_AK = 0, L_AV = 448 * AK_ROW, ATT_LDS_END = L_AV + 448 * AK_ROW;
static_assert(ATT_LDS_END <= LDS_BYTES - 16, "attention LDS");
__device__ __forceinline__ void phase_attn(const Params& P, LAS unsigned char* lds, bf16_t* ogdst) {
    unsigned char* ws = P.ws;
    const bf16_t* Kb = (const bf16_t*)(ws + WS_RZ); const bf16_t* VT = (const bf16_t*)(ws + WS_RZ + 64 * MiB); const bf16_t* Qb = (const bf16_t*)(ws + WS_RZ + 128 * MiB);
    const bf16_t* Gb = (const bf16_t*)(ws + WS_RZ + 192 * MiB);
    const int tid = threadIdx.x, w = __builtin_amdgcn_readfirstlane(tid >> 6), lane = tid & 63, h2 = lane >> 5, r32 = lane & 31;
    bf16x8 U[2];
#pragma unroll
    for (int s = 0; s < 2; ++s)
#pragma unroll
        for (int j = 0; j < 8; ++j) { const int key = 16 * s + 8 * (j >> 2) + 4 * h2 + (j & 3); U[s][j] = (key > r32) ? (short)0x3F80 : (short)0; }
    u32x4 tk[7], tv[7];
#define ATT_WIN_LOAD(it_) do { const int _qt0 = (15 - ((it_) >> 7)) * 8, _bh = (it_) & 127; const int _wlo = _qt0 > 6 ? _qt0 - 6 : 0; const int _nk = (_qt0 + 8 - _wlo) * 32; \
        const bf16_t* _Kp = Kb + (size_t)_bh * SEQ * 64 + (size_t)(_wlo * 32) * 64; const bf16_t* _Vp = VT + (size_t)_bh * SEQ * 64 + (size_t)(_wlo * 32) * 64; \
        _Pragma("unroll") for (int i = 0; i < 7; ++i) { const int pc = tid + 512 * i; if (pc < _nk * 8) { tk[i] = *(const u32x4*)(_Kp + (size_t)pc * 8); tv[i] = *(const u32x4*)(_Vp + (size_t)pc * 8); } } } while (0)
    if ((int)blockIdx.x < 128 * 16) ATT_WIN_LOAD((int)blockIdx.x);
    for (int item = blockIdx.x; item < 128 * 16; item += gridDim.x) {
        const int qb = 15 - (item >> 7), bh = item & 127; const int qt0 = qb * 8; const int wlo = qt0 > 6 ? qt0 - 6 : 0; const int nk = (qt0 + 8 - wlo) * 32;
        const bf16_t* Kp = Kb + (size_t)bh * SEQ * 64; const bf16_t* Vp = VT + (size_t)bh * SEQ * 64; const bf16_t* Qp = Qb + (size_t)bh * SEQ * 64;
        const int qt = qt0 + w, q0 = qt * 32;
        bf16x8 qf[4];
#pragma unroll
        for (int ks = 0; ks < 4; ++ks) qf[ks] = *(const bf16x8*)(Qp + (size_t)(q0 + r32) * 64 + 16 * ks + 8 * h2);
        __syncthreads();
        {
#pragma unroll
            for (int i = 0; i < 7; ++i) { const int pc = tid + 512 * i;
                if (pc < nk * 8) { *(LAS u32x4*)(lds + L_AK + (pc >> 3) * AK_ROW + (pc & 7) * 16) = tk[i];
                    *(LAS u32x4*)(lds + L_AV + (pc >> 3) * AK_ROW + (pc & 7) * 16) = tv[i]; } } }
        __syncthreads();
        asm volatile("s_waitcnt vmcnt(0)" ::: "memory");
        if (item + (int)gridDim.x < 128 * 16) ATT_WIN_LOAD(item + (int)gridDim.x);
        f32x16 o0, o1;
#pragma unroll
        for (int i = 0; i < 16; ++i) { o0[i] = 0.f; o1[i] = 0.f; }
        float carry = 0.f;
        for (int kt = qt; kt >= 0; --kt) {
            const int k0 = kt * 32; const bool diag = (kt == qt);
            bf16x8 kf[4], vf[2][2];
            if (kt >= wlo) { const int kl = (kt - wlo) * 32;
#pragma unroll
                for (int ks = 0; ks < 4; ++ks) kf[ks] = *(const LAS bf16x8*)(lds + L_AK + (kl + r32) * AK_ROW + (16 * ks + 8 * h2) * 2);
#pragma unroll
                for (int dt = 0; dt < 2; ++dt)
#pragma unroll
                    for (int s = 0; s < 2; ++s) {
                        const LAS unsigned char* vp = lds + L_AV + (kl + 16 * s + 4 * h2 + ((lane & 15) >> 2)) * AK_ROW + dt * 64 + ((lane >> 4) & 1) * 32 + (lane & 3) * 8;
                        const s16x4 t0v = __builtin_amdgcn_ds_read_tr16_b64_v4i16((LAS s16x4*)vp), t1v = __builtin_amdgcn_ds_read_tr16_b64_v4i16((LAS s16x4*)(vp + 8 * AK_ROW));
                        bf16x8 f; f[0] = t0v[0]; f[1] = t0v[1]; f[2] = t0v[2]; f[3] = t0v[3]; f[4] = t1v[0]; f[5] = t1v[1]; f[6] = t1v[2]; f[7] = t1v[3];
                        vf[dt][s] = f; }
            } else {
#pragma unroll
                for (int ks = 0; ks < 4; ++ks) kf[ks] = *(const bf16x8*)(Kp + (size_t)(k0 + r32) * 64 + 16 * ks + 8 * h2);
#pragma unroll
                for (int dt = 0; dt < 2; ++dt)
#pragma unroll
                    for (int s = 0; s < 2; ++s) { bf16x8 f;
#pragma unroll
                        for (int j = 0; j < 8; ++j) f[j] = (short)Vp[(size_t)(k0 + 16 * s + 8 * (j >> 2) + 4 * h2 + (j & 3)) * 64 + 32 * dt + r32];
                        vf[dt][s] = f; }
            }
            f32x16 S;
#pragma unroll
            for (int i = 0; i < 16; ++i) S[i] = 0.f;
#pragma unroll
            for (int ks = 0; ks < 4; ++ks) S = __builtin_amdgcn_mfma_f32_32x32x16_bf16(kf[ks], qf[ks], S, 0, 0, 0);
            float lk[16];
#pragma unroll
            for (int r = 0; r < 16; ++r) { const float z = S[r]; const float e = __builtin_amdgcn_exp2f(-fabsf(z));
                float v = -(__builtin_amdgcn_fmed3f(z, 0.f, 3.0e38f) + __builtin_amdgcn_logf(1.0f + e));
                if (diag) { const int key = (r & 3) + 8 * (r >> 2) + 4 * h2; v = (key < r32) ? v : 0.f; }
                lk[r] = v; }
            bf16x8 lf[2];
#pragma unroll
            for (int s = 0; s < 2; ++s) { u32x4 t;
#pragma unroll
                for (int i = 0; i < 4; ++i) t[i] = cvt_pk_bf16(lk[8 * s + 2 * i], lk[8 * s + 2 * i + 1]);
                lf[s] = __builtin_bit_cast(bf16x8, t); }
            f32x16 Suf;
#pragma unroll
            for (int i = 0; i < 16; ++i) Suf[i] = 0.f;
            Suf = __builtin_amdgcn_mfma_f32_32x32x16_bf16(U[0], lf[0], Suf, 0, 0, 0);
            Suf = __builtin_amdgcn_mfma_f32_32x32x16_bf16(U[1], lf[1], Suf, 0, 0, 0);
            const unsigned tkey0 = __float_as_uint(Suf[0] + __uint_as_float(cvt_pk_bf16(lk[0], 0.f) << 16));
            const float tot = __uint_as_float(__builtin_amdgcn_permlane32_swap(tkey0, tkey0, false, false)[0]);
            float pw[16];
#pragma unroll
            for (int r = 0; r < 16; ++r) { float wv = __builtin_amdgcn_exp2f(S[r] + lk[r] + Suf[r] + carry);
                if (diag) { const int key = (r & 3) + 8 * (r >> 2) + 4 * h2; wv = (key < r32) ? wv : 0.f; }
                pw[r] = wv; }
            bf16x8 pf[2];
#pragma unroll
            for (int s = 0; s < 2; ++s) { u32x4 t;
#pragma unroll
                for (int i = 0; i < 4; ++i) t[i] = cvt_pk_bf16(pw[8 * s + 2 * i], pw[8 * s + 2 * i + 1]);
                pf[s] = __builtin_bit_cast(bf16x8, t); }
            o0 = __builtin_amdgcn_mfma_f32_32x32x16_bf16(vf[0][0], pf[0], o0, 0, 0, 0);
            o0 = __builtin_amdgcn_mfma_f32_32x32x16_bf16(vf[0][1], pf[1], o0, 0, 0, 0);
            o1 = __builtin_amdgcn_mfma_f32_32x32x16_bf16(vf[1][0], pf[0], o1, 0, 0, 0);
            o1 = __builtin_amdgcn_mfma_f32_32x32x16_bf16(vf[1][1], pf[1], o1, 0, 0, 0);
            carry += tot;
            if (__all(carry < -160.0f)) break;
        }
        const int b = bh >> 4, head = bh & 15; const bf16_t* gp = Gb + (size_t)(b * SEQ + q0 + r32) * DM + head * 64; bf16_t* ogp = ogdst + (size_t)(b * SEQ + q0 + r32) * DM + head * 64;
#pragma unroll
        for (int dt = 0; dt < 2; ++dt)
#pragma unroll
            for (int gq = 0; gq < 4; ++gq) { const int d0 = 32 * dt + 8 * gq + 4 * h2; const u32x2 gv = *(const u32x2*)(gp + d0); u32x2 ov;
                const float a0 = dt ? o1[4 * gq] : o0[4 * gq], a1 = dt ? o1[4 * gq + 1] : o0[4 * gq + 1], a2 = dt ? o1[4 * gq + 2] : o0[4 * gq + 2], a3 = dt ? o1[4 * gq + 3] : o0[4 * gq + 3];
                ov[0] = cvt_pk_bf16(a0 * bf_lo(gv[0]), a1 * bf_hi(gv[0])); ov[1] = cvt_pk_bf16(a2 * bf_lo(gv[1]), a3 * bf_hi(gv[1]));
                *(u32x2*)(ogp + d0) = ov; }
    }
    __syncthreads();
}

#define XB_TMO      128
#define XB_XCNT(j)  (256  + 64 * (j))
#define XB_XSUB(j)  (1280 + 64 * (j))
#define XB_XGEN(j)  (2304 + 64 * (j))
#define XB_TOP      3328
#define XB_TOPGEN   3392
#define XCD_BAR_WORDS 3456
#define XB_SPIN_CAP (1u << 22)
__device__ __forceinline__ unsigned xb_ld(unsigned* p)              { return __hip_atomic_load(p, __ATOMIC_RELAXED, __HIP_MEMORY_SCOPE_AGENT); }
__device__ __forceinline__ unsigned xb_add(unsigned* p, unsigned v) { return __hip_atomic_fetch_add(p, v, __ATOMIC_RELAXED, __HIP_MEMORY_SCOPE_AGENT); }
__device__ __forceinline__ unsigned xb_xcc_id() { return (unsigned)__builtin_amdgcn_s_getreg((3 << 11) | 20) & 0xFu; }
#define XB_SPIN(cond, bar) do { unsigned _sp = 0; while (cond) { __builtin_amdgcn_s_sleep(1); \
    if ((++_sp & 255u) == 0u) { if (xb_ld(&(bar)[XB_TMO])) break; if (_sp > XB_SPIN_CAP) { atomicAdd(&(bar)[XB_TMO], 1u); break; } } } } while (0)
struct XcdBarrier { unsigned* bar; unsigned x; volatile LAS unsigned* st; };
__device__ __forceinline__ XcdBarrier xcd_barrier_post(unsigned* bar, volatile LAS unsigned* st) {
    XcdBarrier b; b.bar = bar; b.x = xb_xcc_id(); b.st = st;
    if (threadIdx.x == 0) (void)xb_add(&bar[XB_XCNT(b.x)], 1u);
    return b;
}
__device__ __forceinline__ void xcd_barrier_complete(unsigned* bar, unsigned x, unsigned& nloc, unsigned& nx) {
    const unsigned G = gridDim.x * gridDim.y * gridDim.z;
    unsigned sum, cnt, mine, sp = 0u;
    for (;;) {
        sum = 0u; cnt = 0u; mine = 0u;
#pragma unroll
        for (unsigned j = 0; j < 16; ++j) { const unsigned c = xb_ld(&bar[XB_XCNT(j)]); sum += c; cnt += (c > 0u) ? 1u : 0u; mine = (j == x) ? c : mine; }
        if (sum == G) break;
        __builtin_amdgcn_s_sleep(1);
        if ((++sp & 255u) == 0u) { if (xb_ld(&bar[XB_TMO])) break; if (sp > XB_SPIN_CAP) { atomicAdd(&bar[XB_TMO], 1u); break; } }
    }
    nloc = mine > 0u ? mine : 1u; nx = cnt > 0u ? cnt : 1u;
}
__device__ __forceinline__ void xcd_barrier(const XcdBarrier& b) {
    asm volatile("s_waitcnt vmcnt(0)" ::: "memory");
    __syncthreads();
    if (threadIdx.x == 0) {
        unsigned* bar = b.bar;
        __builtin_amdgcn_s_waitcnt(0);
        unsigned nloc = b.st[0], nx = b.st[1];
        if (nloc == 0u) { xcd_barrier_complete(bar, b.x, nloc, nx); b.st[0] = nloc; b.st[1] = nx; }
        const unsigned old = xb_add(&bar[XB_XSUB(b.x)], 1u);
        const unsigned gen = old / nloc;
        if (old + 1u == (gen + 1u) * nloc) {
            __builtin_amdgcn_fence(__ATOMIC_RELEASE, "agent");
            asm volatile("s_waitcnt vmcnt(0)" ::: "memory");
            const unsigned og = xb_add(&bar[XB_TOP], 1u);
            const unsigned tg = og / nx;
            if (og + 1u == (tg + 1u) * nx) xb_add(&bar[XB_TOPGEN], 1u);
            else XB_SPIN(xb_ld(&bar[XB_TOPGEN]) == tg, bar);
            __builtin_amdgcn_fence(__ATOMIC_ACQUIRE, "agent");
            xb_add(&bar[XB_XGEN(b.x)], 1u);
            asm volatile("s_waitcnt vmcnt(0)" ::: "memory");
        } else {
            XB_SPIN(xb_ld(&bar[XB_XGEN(b.x)]) == gen, bar);
            __builtin_amdgcn_fence(__ATOMIC_ACQUIRE, "agent");
            asm volatile("s_waitcnt vmcnt(0)" ::: "memory");
        }
    }
    __syncthreads();
}

constexpr int NPHASE = 11;
__global__ void __launch_bounds__(NTHREADS, 2) fwd_megakernel(Params P) {
    extern __shared__ __attribute__((aligned(16))) unsigned char lds_raw[];
    LAS unsigned char* lds = (LAS unsigned char*)lds_raw;
    cg::grid_group grid = cg::this_grid();
    if (P.ph_lo < 0) grid.sync();
    unsigned char* ws = P.ws;
    const int G = gridDim.x, c = blockIdx.x;
    bf16_t* Z = (bf16_t*)(ws + WS_RZ);
    float* ST = (float*)(ws + WS_ST); float* ST2 = (float*)(ws + WS_ST2);
    volatile LAS unsigned* xst = (volatile LAS unsigned*)(lds + LDS_BYTES - 16);
    if (threadIdx.x == 0) { xst[0] = 0u; xst[1] = 0u; }
    __syncthreads();
    XcdBarrier xbar = xcd_barrier_post((unsigned*)(ws + WS_BAR), xst);
#define IN(k) (P.ph_lo <= (k) && (k) < P.ph_hi)
#define SEAM(k) do { if (IN((k) + 1)) xcd_barrier(xbar); } while (0)
    if (IN(0)) {
        phase_prep(P);
        SEAM(0); }
    if (IN(1)) {
        phase_dt(P);
        pg8::Gemm g{(const bf16_t*)(ws + WS_RA), (const bf16_t*)(ws + WS_W1T), T_TOK, ZW, 1024, 1024}; pg8::StaticOrder S; S.init(T_TOK, ZW, G, c);
        EpiZ E{Z, (bf16_t*)(ws + WS_RZ + RZ_XR), (bf16_t*)(ws + WS_RZ + RZ_BCR)};
        pg8::gemm_phase(lds, g, S, E); SEAM(1); }
    if (IN(2)) {
        phase_conv(P);
        SEAM(2); }
    if (IN(3)) {
        phase_ssd(P, lds, Z, ZW);
        SEAM(3); }
    if (IN(5)) {
        pg8::Gemm g{Z, (const bf16_t*)(ws + WS_W2T), T_TOK, 1024, 2048, 64}; pg8::StaticOrder S; S.init(T_TOK, 1024, G, c);
        EpiH<true, false, false, true> E{(const float*)(ws + WS_HSQ), (LAS float*)(lds + pg8::STAGE_BYTES), P.x, nullptr, 0, nullptr, 0, nullptr, nullptr, (bf16_t*)(ws + WS_RZ + RZ_XR), 1024, ST};
        pg8::gemm_phase<EpiH<true, false, false, true>, true>(lds, g, S, E);
        SEAM(5); }
    if (IN(6)) {
        { pg8::Gemm g{(const bf16_t*)(ws + WS_RA), (const bf16_t*)(ws + WS_WP0), T_TOK, 1024, 256, 256}; pg8::StaticOrder S; S.init(T_TOK, 1024, G, c);
          EpiBf E{(bf16_t*)(ws + WS_RZ + 192 * MiB), 1024};
          pg8::gemm_phase(lds, g, S, E); }
        { pg8::Gemm g{(const bf16_t*)(ws + WS_RZ + RZ_XR), (const bf16_t*)(ws + WS_WG0), T_TOK, 1024, 1024, 1024}; pg8::StaticOrder S; S.init(T_TOK, 1024, G, c);
          EpiH<false, true, false> E{nullptr, nullptr, nullptr, (const bf16_t*)(ws + WS_RZ + RZ_XR), 1024, (const bf16_t*)(ws + WS_RZ + 192 * MiB), 1024, ST, nullptr, (bf16_t*)(ws + WS_RB), 1024, ST2};
          pg8::gemm_phase(lds, g, S, E); }
        SEAM(6); }
    if (IN(7)) {
        pg8::Gemm g{(const bf16_t*)(ws + WS_RB), (const bf16_t*)(ws + WS_WKVQG), T_TOK, 4096, 1024, 1024}; pg8::StaticOrder S; S.init(T_TOK, 4096, G, c);
        EpiKvqg E{ST2, Z, (bf16_t*)(ws + WS_RZ + 64 * MiB), (bf16_t*)(ws + WS_RZ + 128 * MiB), (bf16_t*)(ws + WS_RZ + 192 * MiB), P.k_norm, P.q_norm};
        pg8::gemm_phase(lds, g, S, E);
        SEAM(7); }
    if (IN(8)) {
        phase_attn(P, lds, (bf16_t*)(ws + WS_RZ + 192 * MiB));
        SEAM(8); }
    if (IN(9)) {
        pg8::Gemm g{(const bf16_t*)(ws + WS_RZ + 192 * MiB), (const bf16_t*)(ws + WS_WSO), T_TOK, 1024, 1024, 1024}; pg8::StaticOrder S; S.init(T_TOK, 1024, G, c);
        EpiH<false, false, false> E{nullptr, nullptr, nullptr, (const bf16_t*)(ws + WS_RB), 1024, nullptr, 0, nullptr, nullptr, (bf16_t*)(ws + WS_RZ + 256 * MiB), 1024, ST};
        pg8::gemm_phase(lds, g, S, E);
        SEAM(9); }
    if (IN(10)) {
        { pg8::Gemm g{(const bf16_t*)(ws + WS_RA + 16 * MiB), (const bf16_t*)(ws + WS_WP1), T_TOK, 1024, 256, 256}; pg8::StaticOrder S; S.init(T_TOK, 1024, G, c);
          EpiBf E{Z, 1024}; pg8::gemm_phase(lds, g, S, E); }
        { pg8::Gemm g{(const bf16_t*)(ws + WS_RZ + 256 * MiB), (const bf16_t*)(ws + WS_WG1), T_TOK, 1024, 1024, 1024}; pg8::StaticOrder S; S.init(T_TOK, 1024, G, c);
          EpiH<false, true, true> E{nullptr, nullptr, nullptr, (const bf16_t*)(ws + WS_RZ + 256 * MiB), 1024, Z, 1024, ST, P.out, nullptr, 0, nullptr};
          pg8::gemm_phase(lds, g, S, E); }
    }
#undef IN
#undef SEAM
}

extern "C" void kernel_launch(void* const* d_in, const int* in_sizes, int n_in, void* d_out, int out_size, void* d_ws, size_t ws_size, hipStream_t stream) {
    static int grid_blocks = 0;
    if (!grid_blocks) {
        int dev = 0, cus = 0, per_cu = 0;
        (void)hipGetDevice(&dev);
        (void)hipDeviceGetAttribute(&cus, hipDeviceAttributeMultiprocessorCount, dev);
        if (hipFuncSetAttribute((const void*)fwd_megakernel, hipFuncAttributeMaxDynamicSharedMemorySize, LDS_BYTES) != hipSuccess) fprintf(stderr, "hipFuncSetAttribute failed\n");
        if (hipOccupancyMaxActiveBlocksPerMultiprocessor(&per_cu, (const void*)fwd_megakernel, NTHREADS, LDS_BYTES) != hipSuccess || per_cu < 1) { fprintf(stderr, "occupancy query: %d\n", per_cu); per_cu = 1; }
        (void)hipGetLastError();
        grid_blocks = cus * per_cu;
        if (ws_size < WS_END) fprintf(stderr, "workspace too small: %zu < %zu\n", ws_size, (size_t)WS_END);
    }
    Params P{};
    P.x = (const float*)d_in[0]; P.p = (const float*)d_in[1]; P.m_norm = (const float*)d_in[2]; P.m_in = (const float*)d_in[3]; P.m_conv_w = (const float*)d_in[4];
    P.m_conv_b = (const float*)d_in[5]; P.m_dt_bias = (const float*)d_in[6]; P.m_A_log = (const float*)d_in[7]; P.m_D = (const float*)d_in[8]; P.m_ynorm = (const float*)d_in[9];
    P.m_out = (const float*)d_in[10]; P.kv_norm = (const float*)d_in[11]; P.w_kv = (const float*)d_in[12]; P.k_norm = (const float*)d_in[13]; P.s_norm = (const float*)d_in[14];
    P.s_in = (const float*)d_in[15]; P.q_norm = (const float*)d_in[16]; P.s_out = (const float*)d_in[17]; P.ple_norm = (const float*)d_in[18]; P.ple_gate = (const float*)d_in[19];
    P.ple_proj = (const float*)d_in[20];
    P.out = (float*)d_out; P.ws = (unsigned char*)d_ws; P.ph_lo = 0; P.ph_hi = NPHASE;
    (void)hipMemsetAsync((char*)d_ws + WS_BAR, 0, 16384, stream);
    void* args[] = {&P};
    hipError_t e = hipLaunchCooperativeKernel((const void*)fwd_megakernel, dim3(grid_blocks), dim3(NTHREADS), args, LDS_BYTES, stream);
    if (e != hipSuccess) fprintf(stderr, "cooperative launch failed: %s (grid %d)\n", hipGetErrorString(e), grid_blocks);
}
```

```cpp
#include <hip/hip_runtime.h>
#include <hip/hip_cooperative_groups.h>
#include <cstdio>
namespace cg = cooperative_groups;

#define LAS __attribute__((address_space(3)))
typedef unsigned short bf16_t;
typedef short bf16x8 __attribute__((ext_vector_type(8)));
typedef float f32x4 __attribute__((ext_vector_type(4)));
typedef float f32x16 __attribute__((ext_vector_type(16)));
typedef unsigned u32x4 __attribute__((ext_vector_type(4)));
typedef unsigned u32x2 __attribute__((ext_vector_type(2)));
typedef short s16x4 __attribute__((ext_vector_type(4)));

constexpr int T_TOK = 32768, DM = 1024, SEQ = 4096, NBATCH = 8;
constexpr int DI = 2048, NHS = 32, NIN = 5152, CONVD = 3072;
constexpr int ZW = 5120;
constexpr int N1P = 5376;
constexpr float EPS = 1e-6f;
constexpr int NTHREADS = 512;

constexpr size_t MiB = 1ull << 20;
constexpr size_t WS_W1T = 0;
constexpr size_t WS_W2T = WS_W1T + (size_t)N1P * 1024 * 2;
constexpr size_t WS_WG0 = WS_W2T + 4 * MiB;
constexpr size_t WS_WG1 = WS_WG0 + 2 * MiB;
constexpr size_t WS_WP0 = WS_WG1 + 2 * MiB;
constexpr size_t WS_WP1 = WS_WP0 + MiB / 2;
constexpr size_t WS_WKVQG = WS_WP1 + MiB / 2;
constexpr size_t WS_WSO = WS_WKVQG + 8 * MiB;
constexpr size_t WS_RA = 30 * MiB;
constexpr size_t WS_RB = WS_RA + 64 * MiB;
constexpr size_t WS_RZ = WS_RB + 64 * MiB;
constexpr size_t WS_DT = WS_RZ + 320 * MiB;
constexpr size_t WS_HSQ = WS_DT + 4 * MiB;
constexpr size_t WS_ST = WS_HSQ + 4 * MiB;
constexpr size_t WS_ST2 = WS_ST + 2 * MiB;
constexpr size_t WS_BAR = WS_ST2 + 2 * MiB;
constexpr size_t WS_ACH = WS_BAR + 16384;
constexpr size_t WS_DTH = WS_ACH + 4 * MiB;
constexpr size_t WS_SCH = WS_DTH + 4 * MiB;
constexpr size_t WS_DWH = WS_SCH + 4 * MiB;
constexpr size_t WS_END = WS_DWH + 4 * MiB;
static_assert(WS_WSO + 2 * MiB <= WS_RA, "weights overflow");
static_assert(WS_END <= 512 * MiB, "workspace overflow");

struct Params {
    const float* x; const float* p; const float* m_norm; const float* m_in; const float* m_conv_w; const float* m_conv_b;
    const float* m_dt_bias; const float* m_A_log; const float* m_D; const float* m_ynorm; const float* m_out;
    const float* kv_norm; const float* w_kv; const float* k_norm; const float* s_norm; const float* s_in; const float* q_norm;
    const float* s_out; const float* ple_norm; const float* ple_gate; const float* ple_proj;
    float* out; unsigned char* ws; int ph_lo, ph_hi;
};

typedef __bf16 bf16x2_t __attribute__((ext_vector_type(2)));
typedef float f32x2_t __attribute__((ext_vector_type(2)));
__device__ __forceinline__ unsigned cvt_pk_bf16(float lo, float hi) { f32x2_t v = {lo, hi}; bf16x2_t b = __builtin_convertvector(v, bf16x2_t); return __builtin_bit_cast(unsigned, b); }
__device__ __forceinline__ float bf_lo(unsigned u) { return __uint_as_float(u << 16); }
__device__ __forceinline__ float bf_hi(unsigned u) { return __uint_as_float(u & 0xffff0000u); }
__device__ __forceinline__ float bf2f(bf16_t b) { return __uint_as_float(((unsigned)b) << 16); }
__device__ __forceinline__ float silu_f(float v) { return v * __builtin_amdgcn_rcpf(1.0f + __expf(-v)); }
__device__ __forceinline__ float sigmoid_f(float v) { return __builtin_amdgcn_rcpf(1.0f + __expf(-v)); }
__device__ __forceinline__ u32x4 pack8(const float* v) { u32x4 r; r[0] = cvt_pk_bf16(v[0], v[1]); r[1] = cvt_pk_bf16(v[2], v[3]); r[2] = cvt_pk_bf16(v[4], v[5]); r[3] = cvt_pk_bf16(v[6], v[7]); return r; }

namespace pg8 {
constexpr int BM = 256, BK = 64, HALF = 128, HTB = HALF * BK * 2, STAGE_BYTES = 8 * HTB, NXCD = 8, WGM = 8;
__device__ __forceinline__ int lds_byte(int r, int c) { const int st = (r >> 4) * 2 + (c >> 5), rr = r & 15, cc = c & 31, ob = rr * 64 + cc * 2; return st * 1024 + (ob ^ (((ob >> 9) & 1) << 5)); }
__device__ __forceinline__ void stage_rc(int b, int& R, int& C) { const int st = b / 1024, sb = b % 1024, swz = sb ^ (((sb >> 9) & 1) << 5); R = (st >> 1) * 16 + swz / 64; C = (st & 1) * 32 + (swz % 64) / 2; }
__device__ __forceinline__ int perm32(int rho) { const int n = rho >> 4, i = rho & 15; return 8 * (i >> 2) + 4 * n + (i & 3); }
struct Unit { int pm, pn; };
struct Gemm { const bf16_t* A; const bf16_t* Bt; int M, N, K, lda; };
struct StaticOrder {
    int nM, nN, nwg, G, c;
    __device__ void init(int M, int N, int G_, int c_) { nM = M / BM; nN = N / BM; nwg = nM * nN; G = G_; c = c_; }
    __device__ bool next(int i, Unit& u) const {
        const long L = (long)i * G + c; if (L >= nwg) return false;
        int wgid = (int)L; { const int q = nwg / NXCD, r = nwg % NXCD, xcd = wgid % NXCD, off = wgid / NXCD; wgid = (xcd < r ? xcd * (q + 1) : r * (q + 1) + (xcd - r) * q) + off; }
        const int nig = WGM * nN, gid = wgid / nig, fm = gid * WGM, gsz = (nM - fm) < WGM ? (nM - fm) : WGM;
        u.pm = fm + ((wgid % nig) % gsz); u.pn = (wgid % nig) / gsz; return true;
    }
};
template <class Epi, bool TILEDA = false>
__device__ __forceinline__ void gemm_phase(LAS unsigned char* lds, const Gemm g, const StaticOrder& S, const Epi& E) {
    typename Epi::KState kst;
    const int tid = threadIdx.x, wid = __builtin_amdgcn_readfirstlane(tid >> 6), lane = tid & 63, wr = wid >> 2, wc = wid & 3, fr = lane & 15, fq = lane >> 4;
    const int K = g.K, nt = K / BK, lda = g.lda;
    unsigned voffA[2], voffB[2];
#pragma unroll
    for (int i = 0; i < 2; ++i) { int R, C; stage_rc(tid * 16 + i * 8192, R, C); const int Rb = (R & ~31) + perm32(R & 31);
        voffA[i] = (unsigned)(R * lda + C) * 2u; voffB[i] = (unsigned)(Rb * K + C) * 2u; }
    const size_t kstep = (size_t)(BK * 2), kstepA = TILEDA ? (size_t)(128 * 64 * 2) : (size_t)(BK * 2);
    const size_t hstepA = TILEDA ? (size_t)(32 * 128 * 64 * 2) : (size_t)HALF * lda * 2, hstepB = (size_t)HALF * K * 2;
    const size_t tstepA = 2 * hstepA, tstepB = 2 * hstepB;
    const unsigned ldsw = (unsigned)wid * 1024u;
    const int aoff = lds_byte(wr * 64 + fr, fq * 8), boff = lds_byte(wc * 32 + fr, fq * 8);
#define PG8_SA(b, h) (((b) * 2 + (h)) * HTB)
#define PG8_SB(b, h) ((4 + (b) * 2 + (h)) * HTB)
#define PG8_STAGE(bufoff, gbase, voff) do { _Pragma("unroll") for (int _i = 0; _i < 2; ++_i) \
        __builtin_amdgcn_global_load_lds((const unsigned*)((const char*)(gbase) + (voff)[_i]), (LAS unsigned*)(lds + (bufoff) + ldsw + _i * 8192), 16, 0, 0); } while (0)
#define PG8_LDA(dst, b, h) do { _Pragma("unroll") for (int m = 0; m < 4; ++m) _Pragma("unroll") for (int k = 0; k < 2; ++k) dst[m][k] = *(const LAS bf16x8*)(lds + PG8_SA(b, h) + aoff + m * 2048 + k * 1024); } while (0)
#define PG8_LDB(dst, b, h) do { _Pragma("unroll") for (int n = 0; n < 2; ++n) _Pragma("unroll") for (int k = 0; k < 2; ++k) dst[n][k] = *(const LAS bf16x8*)(lds + PG8_SB(b, h) + boff + n * 2048 + k * 1024); } while (0)
#define PG8_MMA(ai, bj, At, Bt) do { __builtin_amdgcn_s_setprio(1); _Pragma("unroll") for (int m = 0; m < 4; ++m) _Pragma("unroll") for (int n = 0; n < 2; ++n) _Pragma("unroll") for (int k = 0; k < 2; ++k) \
        acc[ai][bj][m][n] = __builtin_amdgcn_mfma_f32_16x16x32_bf16(Bt[n][k], At[m][k], acc[ai][bj][m][n], 0, 0, 0); __builtin_amdgcn_s_setprio(0); } while (0)
#define PG8_WAIT_V(n) asm volatile("s_waitcnt vmcnt(" #n ")" ::: "memory")
#define PG8_WAIT_L(n) asm volatile("s_waitcnt lgkmcnt(" #n ")" ::: "memory")
#define PG8_BAR __builtin_amdgcn_s_barrier()
#define PG8_SCHED __builtin_amdgcn_sched_barrier(0)
    Unit cur, nxt; int ui = 0;
    if (!S.next(0, cur)) return;
    f32x4 acc[2][2][4][2];
#pragma unroll
    for (int a = 0; a < 2; ++a)
#pragma unroll
        for (int b = 0; b < 2; ++b)
#pragma unroll
            for (int m = 0; m < 4; ++m)
#pragma unroll
                for (int n = 0; n < 2; ++n) acc[a][b][m][n] = (f32x4){0.f, 0.f, 0.f, 0.f};
    bf16x8 At[4][2], B0[2][2], B1[2][2];
    const char* cA = (const char*)g.A + (size_t)cur.pm * tstepA; const char* cB = (const char*)g.Bt + (size_t)cur.pn * tstepB;
    PG8_STAGE(PG8_SB(0, 0), cB, voffB); PG8_STAGE(PG8_SA(0, 0), cA, voffA); PG8_STAGE(PG8_SB(0, 1), cB + hstepB, voffB); PG8_STAGE(PG8_SA(0, 1), cA + hstepA, voffA);
    if (wr == 1) PG8_BAR;
    PG8_WAIT_V(4); PG8_BAR;
    PG8_STAGE(PG8_SB(1, 0), cB + kstep, voffB); PG8_STAGE(PG8_SA(1, 0), cA + kstepA, voffA); PG8_STAGE(PG8_SB(1, 1), cB + hstepB + kstep, voffB);
    PG8_WAIT_V(6); PG8_BAR;
    for (;;) {
        const bool has_next = S.next(ui + 1, nxt);
        const char* nA = has_next ? (const char*)g.A + (size_t)nxt.pm * tstepA : cA; const char* nB = has_next ? (const char*)g.Bt + (size_t)nxt.pn * tstepB : cB;
        E.kbegin(kst, cur, wr, fr, fq);
        for (int t = 0; t < nt; t += 2) {
            const bool last = (t == nt - 2);
            E.kstep(kst, t, acc);
            const char* a1 = cA + (size_t)(t + 1) * kstepA;
            const char* a2 = last ? nA : cA + (size_t)(t + 2) * kstepA; const char* b2 = last ? nB : cB + (size_t)(t + 2) * kstep;
            const char* a3 = a2 + kstepA; const char* b3 = b2 + kstep;
            PG8_LDB(B0, 0, 0); PG8_SCHED; PG8_LDA(At, 0, 0); PG8_STAGE(PG8_SA(1, 1), a1 + hstepA, voffA);
            PG8_WAIT_L(8); PG8_BAR; PG8_WAIT_L(0); PG8_MMA(0, 0, At, B0); PG8_BAR; PG8_SCHED;
            PG8_LDB(B1, 0, 1); PG8_STAGE(PG8_SB(0, 0), b2, voffB);
            PG8_BAR; PG8_WAIT_L(0); PG8_MMA(0, 1, At, B1); PG8_BAR;
            PG8_LDA(At, 0, 1); PG8_STAGE(PG8_SA(0, 0), a2, voffA);
            PG8_BAR; PG8_WAIT_L(0); PG8_MMA(1, 0, At, B0); PG8_BAR; PG8_SCHED;
            PG8_STAGE(PG8_SB(0, 1), b2 + hstepB, voffB);
            PG8_WAIT_V(6); PG8_BAR; PG8_MMA(1, 1, At, B1); PG8_BAR;
            PG8_LDB(B0, 1, 0); PG8_SCHED; PG8_LDA(At, 1, 0); PG8_STAGE(PG8_SA(0, 1), a2 + hstepA, voffA);
            PG8_WAIT_L(8); PG8_BAR; PG8_WAIT_L(0); PG8_MMA(0, 0, At, B0); PG8_BAR; PG8_SCHED;
            PG8_LDB(B1, 1, 1); PG8_STAGE(PG8_SB(1, 0), b3, voffB);
            PG8_BAR; PG8_WAIT_L(0); PG8_MMA(0, 1, At, B1); PG8_BAR;
            PG8_LDA(At, 1, 1); PG8_STAGE(PG8_SA(1, 0), a3, voffA);
            PG8_BAR; PG8_WAIT_L(0); PG8_MMA(1, 0, At, B0); PG8_BAR; PG8_SCHED;
            PG8_STAGE(PG8_SB(1, 1), b3 + hstepB, voffB);
            PG8_WAIT_V(6); PG8_BAR; PG8_MMA(1, 1, At, B1); PG8_BAR;
        }
        E(acc, cur, wr, wc, fr, fq, kst);
        if (!has_next) break;
#pragma unroll
        for (int a = 0; a < 2; ++a)
#pragma unroll
            for (int b = 0; b < 2; ++b)
#pragma unroll
                for (int m = 0; m < 4; ++m)
#pragma unroll
                    for (int n = 0; n < 2; ++n) acc[a][b][m][n] = (f32x4){0.f, 0.f, 0.f, 0.f};
        cur = nxt; cA = nA; cB = nB; ++ui;
    }
    PG8_WAIT_V(0);
    if (wr == 0) PG8_BAR;
    PG8_BAR;
#undef PG8_SA
#undef PG8_SB
#undef PG8_STAGE
#undef PG8_LDA
#undef PG8_LDB
#undef PG8_MMA
#undef PG8_WAIT_V
#undef PG8_WAIT_L
#undef PG8_BAR
#undef PG8_SCHED
}
}
typedef f32x4 AccT[2][2][4][2];

constexpr size_t RZ_XR = 128 * MiB, RZ_BCR = 256 * MiB;
struct EpiZ {
    struct KState {}; __device__ __forceinline__ void kbegin(KState&, const pg8::Unit&, int, int, int) const {} __device__ __forceinline__ void kstep(KState&, int, AccT&) const {}
    bf16_t* ZT; bf16_t* XR; bf16_t* BCR;
    __device__ __forceinline__ void operator()(const AccT& acc, const pg8::Unit& u, int wr, int wc, int fr, int fq, const KState&) const {
        const int row0 = u.pm * 256 + wr * 64 + fr; const bool act = u.pn < 8;
        if (u.pn < 16) {
            bf16_t* base = act ? ZT : XR; const int hc = (u.pn & 7) * 256 + wc * 32 + 8 * fq;
#pragma unroll
            for (int ai = 0; ai < 2; ++ai)
#pragma unroll
                for (int m = 0; m < 4; ++m) { const int row = row0 + ai * 128 + m * 16;
#pragma unroll
                    for (int bj = 0; bj < 2; ++bj) { f32x4 v0 = acc[ai][bj][m][0], v1 = acc[ai][bj][m][1]; const int c = hc + bj * 128;
                        if (act) {
#pragma unroll
                            for (int j = 0; j < 4; ++j) { v0[j] = silu_f(v0[j]); v1[j] = silu_f(v1[j]); } }
                        u32x4 o; o[0] = cvt_pk_bf16(v0[0], v0[1]); o[1] = cvt_pk_bf16(v0[2], v0[3]); o[2] = cvt_pk_bf16(v1[0], v1[1]); o[3] = cvt_pk_bf16(v1[2], v1[3]);
                        *(u32x4*)(base + ((size_t)((row >> 7) * 32 + (c >> 6)) * 128 + (row & 127)) * 64 + (c & 63)) = o; } }
        } else {
            const int c0 = (u.pn - 16) * 256 + wc * 32 + 8 * fq;
#pragma unroll
            for (int ai = 0; ai < 2; ++ai)
#pragma unroll
                for (int m = 0; m < 4; ++m) { bf16_t* rowp = BCR + (size_t)(row0 + ai * 128 + m * 16) * 1024 + c0;
#pragma unroll
                    for (int bj = 0; bj < 2; ++bj) { const f32x4 v0 = acc[ai][bj][m][0], v1 = acc[ai][bj][m][1];
                        u32x4 o; o[0] = cvt_pk_bf16(v0[0], v0[1]); o[1] = cvt_pk_bf16(v0[2], v0[3]); o[2] = cvt_pk_bf16(v1[0], v1[1]); o[3] = cvt_pk_bf16(v1[2], v1[3]);
                        *(u32x4*)(rowp + bj * 128) = o; } }
        }
    }
};
struct EpiBf {
    struct KState {}; __device__ __forceinline__ void kbegin(KState&, const pg8::Unit&, int, int, int) const {} __device__ __forceinline__ void kstep(KState&, int, AccT&) const {}
    bf16_t* O; int ldo;
    __device__ __forceinline__ void operator()(const AccT& acc, const pg8::Unit& u, int wr, int wc, int fr, int fq, const KState&) const {
        const int row0 = u.pm * 256 + wr * 64 + fr, col0 = u.pn * 256 + wc * 32 + 8 * fq;
#pragma unroll
        for (int ai = 0; ai < 2; ++ai)
#pragma unroll
            for (int m = 0; m < 4; ++m) { bf16_t* rowp = O + (size_t)(row0 + ai * 128 + m * 16) * ldo + col0;
#pragma unroll
                for (int bj = 0; bj < 2; ++bj) { const f32x4 v0 = acc[ai][bj][m][0], v1 = acc[ai][bj][m][1];
                    u32x4 o; o[0] = cvt_pk_bf16(v0[0], v0[1]); o[1] = cvt_pk_bf16(v0[2], v0[3]); o[2] = cvt_pk_bf16(v1[0], v1[1]); o[3] = cvt_pk_bf16(v1[2], v1[3]);
                    *(u32x4*)(rowp + bj * 128) = o; } }
    }
};
__device__ __forceinline__ void rows_rstd(const float* st, int row0, int fq, float (&rs)[8]) {
    f32x4 sv[8];
#pragma unroll
    for (int i = 0; i < 8; ++i) sv[i] = *(const f32x4*)(st + (size_t)(row0 + (i >> 2) * 128 + (i & 3) * 16) * 16 + 4 * fq);
#pragma unroll
    for (int i = 0; i < 8; ++i) { float t = (sv[i][0] + sv[i][1]) + (sv[i][2] + sv[i][3]); t += __shfl_xor(t, 16); t += __shfl_xor(t, 32); rs[i] = rsqrtf(t * (1.0f / DM) + EPS); }
}
template <bool RES_F32, bool PLE, bool OUT_F32, bool GNORM = false>
struct EpiH {
    struct KState {};
    const float* hsq; LAS float* rtab;
    __device__ __forceinline__ void kbegin(KState&, const pg8::Unit& u, int wr, int fr, int fq) const {
        if (GNORM) { const int row0 = u.pm * 256 + wr * 64 + fr; LAS float* tb = rtab + (threadIdx.x >> 6) * 512 + (threadIdx.x & 63);
#pragma unroll
            for (int hlf = 0; hlf < 2; ++hlf) { f32x4 a[4], b[4];
#pragma unroll
                for (int i = 0; i < 4; ++i) { const size_t row = (size_t)(row0 + hlf * 128 + i * 16); a[i] = *(const f32x4*)(hsq + row * 32 + 8 * fq); b[i] = *(const f32x4*)(hsq + row * 32 + 8 * fq + 4); }
#pragma unroll
                for (int i = 0; i < 4; ++i) tb[(hlf * 4 + i) * 64] = rsqrtf(((a[i][0] + a[i][1] + a[i][2] + a[i][3]) + (b[i][0] + b[i][1] + b[i][2] + b[i][3])) * (1.0f / 512.0f) + EPS); } }
    }
    __device__ __forceinline__ void kstep(KState&, int t, AccT& acc) const {
        if (GNORM) { if (t == 8 || t == 16 || t == 24) { const int gdone = (t >> 3) - 1; const int fr = threadIdx.x & 15;
            const LAS float* tb = rtab + (threadIdx.x >> 6) * 512 + fr + 16 * gdone;
#pragma unroll
                for (int i = 0; i < 8; ++i) { const float rg = tb[i * 64], rn = tb[i * 64 + 16]; const float f = rg * __builtin_amdgcn_rcpf(rn);
                    const int ai = i >> 2, m = i & 3;
#pragma unroll
                    for (int bj = 0; bj < 2; ++bj)
#pragma unroll
                        for (int n = 0; n < 2; ++n) acc[ai][bj][m][n] *= f; } } }
    }
    const float* res32; const bf16_t* resb; int ldres;
    const bf16_t* pp; int ldpp; const float* st_in;
    float* out32; bf16_t* hb; int ldhb; float* st_out;
    __device__ __forceinline__ void operator()(const AccT& acc, const pg8::Unit& u, int wr, int wc, int fr, int fq, const KState& kst) const {
        const int row0 = u.pm * 256 + wr * 64 + fr, col0 = u.pn * 256 + wc * 32 + 8 * fq;
        float rs[8];
        if (PLE) rows_rstd(st_in, row0, fq, rs);
        if (GNORM) { const LAS float* tb = rtab + (threadIdx.x >> 6) * 512 + fr + 48;
#pragma unroll
            for (int i = 0; i < 8; ++i) rs[i] = tb[i * 64]; }
#pragma unroll
        for (int g2 = 0; g2 < 4; ++g2) { const int ai = g2 >> 1, mb = (g2 & 1) * 2;
            f32x4 rf[2][2][2]; u32x4 rbv[2][2]; u32x4 pv[2][2];
#pragma unroll
            for (int mm = 0; mm < 2; ++mm) { const int row = row0 + ai * 128 + (mb + mm) * 16;
#pragma unroll
                for (int bj = 0; bj < 2; ++bj) {
                    if (RES_F32) { const float* rp = res32 + (size_t)row * DM + col0 + bj * 128; rf[mm][bj][0] = *(const f32x4*)rp; rf[mm][bj][1] = *(const f32x4*)(rp + 4); }
                    else rbv[mm][bj] = *(const u32x4*)(resb + (size_t)row * ldres + col0 + bj * 128);
                    if (PLE) pv[mm][bj] = *(const u32x4*)(pp + (size_t)row * ldpp + col0 + bj * 128); } }
#pragma unroll
            for (int mm = 0; mm < 2; ++mm) { const int m = mb + mm; const int row = row0 + ai * 128 + m * 16; float ss = 0.f;
#pragma unroll
                for (int bj = 0; bj < 2; ++bj) { float v[8], r[8];
                    if (RES_F32) {
#pragma unroll
                        for (int e = 0; e < 4; ++e) { r[e] = rf[mm][bj][0][e]; r[4 + e] = rf[mm][bj][1][e]; } }
                    else {
#pragma unroll
                        for (int e = 0; e < 4; ++e) { r[2 * e] = bf_lo(rbv[mm][bj][e]); r[2 * e + 1] = bf_hi(rbv[mm][bj][e]); } }
#pragma unroll
                    for (int e = 0; e < 8; ++e) { const float a = acc[ai][bj][m][e >> 2][e & 3];
                        if (PLE) { const unsigned w = pv[mm][bj][e >> 1]; const float pe = (e & 1) ? bf_hi(w) : bf_lo(w); v[e] = r[e] + pe * sigmoid_f(rs[ai * 4 + m] * a); }
                        else v[e] = r[e] + (GNORM ? rs[ai * 4 + m] * a : a);
                        ss += v[e] * v[e]; }
                    if (OUT_F32) { float* op = out32 + (size_t)row * DM + col0 + bj * 128;
                        *(f32x4*)op = (f32x4){v[0], v[1], v[2], v[3]}; *(f32x4*)(op + 4) = (f32x4){v[4], v[5], v[6], v[7]}; }
                    if (hb) *(u32x4*)(hb + (size_t)row * ldhb + col0 + bj * 128) = pack8(v); }
                if (st_out) { ss += __shfl_xor(ss, 16); ss += __shfl_xor(ss, 32);
                    if (fq == 0) st_out[(size_t)row * 16 + u.pn * 4 + wc] = ss; } }
        }
    }
};
struct EpiKvqg {
    struct KState {}; __device__ __forceinline__ void kbegin(KState&, const pg8::Unit&, int, int, int) const {} __device__ __forceinline__ void kstep(KState&, int, AccT&) const {}
    const float* st_in; bf16_t* Kb; bf16_t* VT; bf16_t* Qb; bf16_t* Gb; const float* k_g; const float* q_g;
    __device__ __forceinline__ void operator()(const AccT& acc, const pg8::Unit& u, int wr, int wc, int fr, int fq, const KState&) const {
        const int row0 = u.pm * 256 + wr * 64 + fr; const int sec = u.pn >> 2, head = 4 * (u.pn & 3) + wc;
        float rsv[8]; rows_rstd(st_in, row0, fq, rsv);
        float gnv[2][8];
        if (sec == 0 || sec == 2) { const float* gn = sec == 0 ? k_g : q_g;
#pragma unroll
            for (int bj = 0; bj < 2; ++bj)
#pragma unroll
                for (int e = 0; e < 8; ++e) gnv[bj][e] = gn[32 * bj + 8 * fq + e]; }
#pragma unroll
        for (int ai = 0; ai < 2; ++ai)
#pragma unroll
            for (int m = 0; m < 4; ++m) { const int row = row0 + ai * 128 + m * 16; const float rs = rsv[ai * 4 + m];
                const int b = row >> 12, s = row & 4095;
                float v[2][8];
#pragma unroll
                for (int bj = 0; bj < 2; ++bj)
#pragma unroll
                    for (int n = 0; n < 2; ++n)
#pragma unroll
                        for (int j = 0; j < 4; ++j) v[bj][4 * n + j] = acc[ai][bj][m][n][j] * rs;
                if (sec == 0 || sec == 2) {
                    float ss = 0.f;
#pragma unroll
                    for (int bj = 0; bj < 2; ++bj)
#pragma unroll
                        for (int e = 0; e < 8; ++e) ss += v[bj][e] * v[bj][e];
                    ss += __shfl_xor(ss, 16); ss += __shfl_xor(ss, 32);
                    const float r = rsqrtf(ss * (1.0f / 64.0f) + EPS) * (sec == 2 ? 0.125f * 1.4426950408889634f : 1.0f);
                    bf16_t* dst = (sec == 0 ? Kb : Qb) + ((size_t)(b * 16 + head) * SEQ + s) * 64;
#pragma unroll
                    for (int bj = 0; bj < 2; ++bj) { const int d0 = 32 * bj + 8 * fq; float w[8];
#pragma unroll
                        for (int e = 0; e < 8; ++e) w[e] = v[bj][e] * r * gnv[bj][e];
                        *(u32x4*)(dst + d0) = pack8(w); }
                } else if (sec == 1) {
                    bf16_t* dst = VT + ((size_t)(b * 16 + head) * SEQ + s) * 64;
#pragma unroll
                    for (int bj = 0; bj < 2; ++bj) { const int d0 = 32 * bj + 8 * fq; *(u32x4*)(dst + d0) = pack8(v[bj]); }
                } else {
#pragma unroll
                    for (int bj = 0; bj < 2; ++bj) { const int d0 = 32 * bj + 8 * fq; float w[8];
#pragma unroll
                        for (int e = 0; e < 8; ++e) w[e] = silu_f(v[bj][e]);
                        *(u32x4*)(Gb + (size_t)row * DM + head * 64 + d0) = pack8(w); }
                }
            }
    }
};

template <class F>
__device__ __forceinline__ void wt_cvt(bf16_t* dst, int Ndst, int K, long gtid, long gth, F src) {
    const long items = (long)Ndst * (K / 8);
    for (long i0 = gtid; i0 < items; i0 += 2 * gth) { float v[2][8];
#pragma unroll
        for (int u = 0; u < 2; ++u) { const long i = i0 + u * gth; if (i < items) { const int n = (int)(i % Ndst), k0 = (int)(i / Ndst) * 8;
#pragma unroll
                for (int e = 0; e < 8; ++e) v[u][e] = src(n, k0 + e); } }
#pragma unroll
        for (int u = 0; u < 2; ++u) { const long i = i0 + u * gth; if (i < items) { const int n = (int)(i % Ndst), k0 = (int)(i / Ndst) * 8;
                *(u32x4*)(dst + (size_t)n * K + k0) = pack8(v[u]); } } }
}
__device__ __forceinline__ void phase_prep(const Params& P) {
    unsigned char* ws = P.ws;
    const long gtid = (long)blockIdx.x * NTHREADS + threadIdx.x, gth = (long)gridDim.x * NTHREADS;
    { const float* w = P.m_in; wt_cvt((bf16_t*)(ws + WS_W1T), NIN, 1024, gtid, gth, [=](int n, int k) { return w[(size_t)k * NIN + n]; }); }
    { const float* w = P.m_out; const float* g = P.m_ynorm; wt_cvt((bf16_t*)(ws + WS_W2T), 1024, 2048, gtid, gth, [=](int n, int k) { return w[(size_t)k * 1024 + n] * g[k]; }); }
    for (int i = 0; i < 2; ++i) { const float* w = P.ple_gate + (size_t)i * 1024 * 1024; const float* g = P.ple_norm + i * 1024;
        wt_cvt((bf16_t*)(ws + (i ? WS_WG1 : WS_WG0)), 1024, 1024, gtid, gth, [=](int n, int k) { return w[(size_t)k * 1024 + n] * g[k]; });
        const float* wp = P.ple_proj + (size_t)i * 256 * 1024;
        wt_cvt((bf16_t*)(ws + (i ? WS_WP1 : WS_WP0)), 1024, 256, gtid, gth, [=](int n, int k) { return wp[(size_t)k * 1024 + n]; }); }
    { const float* wkv = P.w_kv; const float* gkv = P.kv_norm; const float* wq = P.s_in; const float* gq = P.s_norm;
        wt_cvt((bf16_t*)(ws + WS_WKVQG), 4096, 1024, gtid, gth, [=](int n, int k) {
            const int pn = n >> 8, cl = n & 255, bj = cl >> 7, wc = (cl >> 5) & 3, i = cl & 31, sec = pn >> 2, head = 4 * (pn & 3) + wc, d = 32 * bj + i;
            const int sc = (sec & 1) * 1024 + head * 64 + d;
            return sec < 2 ? wkv[(size_t)k * 2048 + sc] * gkv[k] : wq[(size_t)k * 2048 + sc] * gq[k]; }); }
    { const float* w = P.s_out; wt_cvt((bf16_t*)(ws + WS_WSO), 1024, 1024, gtid, gth, [=](int n, int k) { return w[(size_t)k * 1024 + n]; }); }
    const int lane = threadIdx.x & 63; const int gw = (int)(gtid >> 6), nw = (int)(gth >> 6);
    bf16_t* u0 = (bf16_t*)(ws + WS_RA);
    f32x4 gm[4];
#pragma unroll
    for (int i = 0; i < 4; ++i) gm[i] = *(const f32x4*)(P.m_norm + i * 256 + lane * 4);
    for (int rowb = gw * 4; rowb < T_TOK; rowb += nw * 4) { f32x4 v[4][4];
#pragma unroll
        for (int r = 0; r < 4; ++r)
#pragma unroll
            for (int i = 0; i < 4; ++i) v[r][i] = *(const f32x4*)(P.x + (size_t)(rowb + r) * DM + i * 256 + lane * 4);
#pragma unroll
        for (int r = 0; r < 4; ++r) { float ss = 0.f;
#pragma unroll
            for (int i = 0; i < 4; ++i) ss += v[r][i][0] * v[r][i][0] + v[r][i][1] * v[r][i][1] + v[r][i][2] * v[r][i][2] + v[r][i][3] * v[r][i][3];
#pragma unroll
            for (int o = 1; o < 64; o <<= 1) ss += __shfl_xor(ss, o);
            const float rs = rsqrtf(ss * (1.0f / DM) + EPS);
#pragma unroll
            for (int i = 0; i < 4; ++i) { u32x2 o;
                o[0] = cvt_pk_bf16(v[r][i][0] * rs * gm[i][0], v[r][i][1] * rs * gm[i][1]); o[1] = cvt_pk_bf16(v[r][i][2] * rs * gm[i][2], v[r][i][3] * rs * gm[i][3]);
                *(u32x2*)(u0 + (size_t)(rowb + r) * DM + i * 256 + lane * 4) = o; } } }
}

__device__ __forceinline__ void phase_dt(const Params& P) {
    const bf16_t* u0 = (const bf16_t*)(P.ws + WS_RA); const bf16_t* Wdt = (const bf16_t*)(P.ws + WS_W1T) + (size_t)5120 * 1024; float* DT = (float*)(P.ws + WS_DT);
    const int tid = threadIdx.x, w = tid >> 6, lane = tid & 63, h2 = lane >> 5, r32 = lane & 31;
    for (int tile = blockIdx.x + gridDim.x * w; tile < T_TOK / 32; tile += gridDim.x * 8) {
        const bf16_t* ap = u0 + (size_t)(tile * 32 + r32) * 1024 + 8 * h2; const bf16_t* bp = Wdt + (size_t)r32 * 1024 + 8 * h2;
        f32x16 acc;
#pragma unroll
        for (int i = 0; i < 16; ++i) acc[i] = 0.f;
#pragma unroll 8
        for (int ks = 0; ks < 64; ++ks) { const bf16x8 a = *(const bf16x8*)(ap + 16 * ks); const bf16x8 bw = *(const bf16x8*)(bp + 16 * ks);
            acc = __builtin_amdgcn_mfma_f32_32x32x16_bf16(a, bw, acc, 0, 0, 0); }
        const float bias = P.m_dt_bias[r32];
#pragma unroll
        for (int r = 0; r < 16; ++r) { const int row = tile * 32 + (r & 3) + 8 * (r >> 2) + 4 * h2; const float xx = acc[r] + bias;
            DT[(size_t)row * 32 + r32] = xx > 20.f ? xx : log1pf(__expf(xx)); }
    }
}

__device__ __forceinline__ void phase_conv(const Params& P) {
    unsigned char* ws = P.ws;
    const long gtid = (long)blockIdx.x * NTHREADS + threadIdx.x, gth = (long)gridDim.x * NTHREADS;
    const bf16_t* BCR = (const bf16_t*)(ws + WS_RZ + RZ_BCR); bf16_t* BC = (bf16_t*)(ws + WS_RB);
    {
      const int cgi = (int)(gtid & 127), ch = 2048 + cgi * 8; const long nitem = (long)(T_TOK / 8) * 128;
      float cw[4][8], cb[8];
#pragma unroll
      for (int j = 0; j < 4; ++j) { const f32x4 a = *(const f32x4*)(P.m_conv_w + j * CONVD + ch), b = *(const f32x4*)(P.m_conv_w + j * CONVD + ch + 4);
#pragma unroll
          for (int e = 0; e < 4; ++e) { cw[j][e] = a[e]; cw[j][4 + e] = b[e]; } }
      { const f32x4 a = *(const f32x4*)(P.m_conv_b + ch), b = *(const f32x4*)(P.m_conv_b + ch + 4);
#pragma unroll
          for (int e = 0; e < 4; ++e) { cb[e] = a[e]; cb[4 + e] = b[e]; } }
      for (long it0 = gtid; it0 < nitem; it0 += 2 * gth) {
        u32x4 raw[2][11];
#pragma unroll
        for (int u = 0; u < 2; ++u) { const long it = it0 + u * gth; if (it < nitem) { const int tg = (int)(it >> 7), t0 = tg * 8, s0 = t0 & 4095;
#pragma unroll
            for (int r = 0; r < 11; ++r) { if (s0 - 3 + r >= 0) raw[u][r] = *(const u32x4*)(BCR + (size_t)(t0 - 3 + r) * 1024 + cgi * 8); else raw[u][r] = (u32x4){0u, 0u, 0u, 0u}; } } }
#pragma unroll
        for (int u = 0; u < 2; ++u) { const long it = it0 + u * gth; if (it < nitem) { const int tg = (int)(it >> 7), t0 = tg * 8;
#pragma unroll
          for (int r = 0; r < 8; ++r) { float o[8];
#pragma unroll
            for (int e = 0; e < 8; ++e) { float a = cb[e];
#pragma unroll
                for (int j = 0; j < 4; ++j) { const unsigned w = raw[u][r + j][e >> 1]; a += cw[j][e] * ((e & 1) ? bf_hi(w) : bf_lo(w)); }
                o[e] = silu_f(a); }
            *(u32x4*)(BC + (size_t)(t0 + r) * 1024 + cgi * 8) = pack8(o); } } }
      } }
    { const float* DTg = (const float*)(ws + WS_DT); float* ACh = (float*)(ws + WS_ACH); float* DTh = (float*)(ws + WS_DTH); float* SCh = (float*)(ws + WS_SCH); float* DWh = (float*)(ws + WS_DWH);
      const int lane = threadIdx.x & 63; const int gw = (int)(gtid >> 6), nw = (int)(gth >> 6);
      for (int it = gw; it < NBATCH * NHS * 32; it += nw) { const int h = it & 31, c = (it >> 5) & 31, b = it >> 10; const int t0 = b * SEQ + c * 128;
        const float Ah = -__expf(P.m_A_log[h]);
        const float d0 = DTg[(size_t)(t0 + lane) * 32 + h], d1 = DTg[(size_t)(t0 + 64 + lane) * 32 + h];
        float a0 = d0 * Ah, a1 = d1 * Ah;
#pragma unroll
        for (int o = 1; o < 64; o <<= 1) { const float t = __shfl_up(a0, o); if (lane >= o) a0 += t; }
#pragma unroll
        for (int o = 1; o < 64; o <<= 1) { const float t = __shfl_up(a1, o); if (lane >= o) a1 += t; }
        a1 += __shfl(a0, 63);
        const float ae = __shfl(a1, 63);
        const size_t o0 = (size_t)(b * 32 + h) * SEQ + c * 128 + lane;
        const float e0 = __shfl(a0, lane | 15), e1 = __shfl(a1, lane | 15);
        ACh[o0] = a0; ACh[o0 + 64] = a1; DTh[o0] = d0; DTh[o0 + 64] = d1; SCh[o0] = d0 * __expf(ae - a0); SCh[o0 + 64] = d1 * __expf(ae - a1);
        DWh[o0] = d0 * __expf(e0 - a0); DWh[o0 + 64] = d1 * __expf(e1 - a1); } }
    bf16_t* pb = (bf16_t*)(ws + WS_RA);
    { const long npb = (long)2 * T_TOK * 256 / 8;
      for (long it0 = gtid; it0 < npb; it0 += 4 * gth) { f32x4 a[4], b[4];
#pragma unroll
        for (int u = 0; u < 4; ++u) { const long it = it0 + u * gth; if (it < npb) { a[u] = *(const f32x4*)(P.p + it * 8); b[u] = *(const f32x4*)(P.p + it * 8 + 4); } }
#pragma unroll
        for (int u = 0; u < 4; ++u) { const long it = it0 + u * gth; if (it < npb) { u32x4 o; o[0] = cvt_pk_bf16(a[u][0], a[u][1]); o[1] = cvt_pk_bf16(a[u][2], a[u][3]); o[2] = cvt_pk_bf16(b[u][0], b[u][1]); o[3] = cvt_pk_bf16(b[u][2], b[u][3]);
            *(u32x4*)(pb + it * 8) = o; } } } }
}

constexpr int SROW = 272;
constexpr int L_B = 0, L_C = 34816, L_XW = 69632  , L_XT = 104448, L_ST = 121856  , L_AC = 156672  , L_SSD_END = 157696;
constexpr int LDS_BYTES = 158720;
static_assert(L_SSD_END <= LDS_BYTES - 16 && pg8::STAGE_BYTES + 16384 <= LDS_BYTES - 16, "LDS");

__device__ __forceinline__ void phase_ssd(const Params& P, LAS unsigned char* lds, bf16_t* ydst, int ldy) {
    unsigned char* ws = P.ws;
    bf16_t* Z = (bf16_t*)(ws + WS_RZ); const bf16_t* BC = (const bf16_t*)(ws + WS_RB);
    const float* ACh = (const float*)(ws + WS_ACH); const float* DTh = (const float*)(ws + WS_DTH); const float* SCh = (const float*)(ws + WS_SCH); const float* DWh = (const float*)(ws + WS_DWH); float* HSQ = (float*)(ws + WS_HSQ);
    const int tid = threadIdx.x, w = __builtin_amdgcn_readfirstlane(tid >> 6), lane = tid & 63, q = lane >> 4, r16 = lane & 15;
    const int lt = w < 4 ? w : 11 - w;
    for (int item = blockIdx.x; item < NBATCH * NHS; item += gridDim.x) {
        const int bg = (item & 7) * 4 + (item >> 6), g = bg & 3, b = bg >> 2, h = g * 8 + ((item >> 3) & 7);
        const float Ah = -__expf(P.m_A_log[h]), Dh = P.m_D[h];
        const bf16_t* XR = (const bf16_t*)(ws + WS_RZ + RZ_XR);
        const int cp2 = (lane & 31) * 2, rb8 = 16 * w + 8 * (lane >> 5); const int xch = h * 64 + cp2;
        bf16x2_t w01a, w23a, w01b, w23b; float cbxa, cbxb;
        { float ca[4], cb4[4];
#pragma unroll
          for (int j = 0; j < 4; ++j) { ca[j] = P.m_conv_w[j * CONVD + xch]; cb4[j] = P.m_conv_w[j * CONVD + xch + 1]; }
          cbxa = P.m_conv_b[xch]; cbxb = P.m_conv_b[xch + 1];
          w01a = __builtin_bit_cast(bf16x2_t, cvt_pk_bf16(ca[0], ca[1])); w23a = __builtin_bit_cast(bf16x2_t, cvt_pk_bf16(ca[2], ca[3]));
          w01b = __builtin_bit_cast(bf16x2_t, cvt_pk_bf16(cb4[0], cb4[1])); w23b = __builtin_bit_cast(bf16x2_t, cvt_pk_bf16(cb4[2], cb4[3])); }
        f32x4 stT[4];
#pragma unroll
        for (int pt = 0; pt < 4; ++pt) stT[pt] = (f32x4){0.f, 0.f, 0.f, 0.f};
        __syncthreads();
        for (int i = tid; i < 2 * 64 * SROW / 4; i += NTHREADS) ((LAS unsigned*)(lds + L_ST))[i] = 0u;
        u32x4 rb[4], rc[4]; unsigned xd[11]; float pac = 0.f, pdt = 0.f, pdw = 0.f; f32x4 psc0, psc1;
        const float* ach = ACh + (size_t)(b * 32 + h) * SEQ; const float* dth = DTh + (size_t)(b * 32 + h) * SEQ; const float* sch = SCh + (size_t)(b * 32 + h) * SEQ; const float* dwh = DWh + (size_t)(b * 32 + h) * SEQ;
#define SSD_LOAD(cc) do { const int _t0 = b * SEQ + (cc) * 128; \
            _Pragma("unroll") for (int i = 0; i < 4; ++i) { const int piece = tid + 512 * i, row = piece >> 4, c16 = piece & 15; \
                rb[i] = *(const u32x4*)(BC + (size_t)(_t0 + row) * 1024 + g * 128 + c16 * 8); \
                rc[i] = *(const u32x4*)(BC + (size_t)(_t0 + row) * 1024 + 512 + g * 128 + c16 * 8); \
                } \
            _Pragma("unroll") for (int i = 0; i < 11; ++i) { const int sl = rb8 - 3 + i; \
                const int tk = (cc) * 128 + sl; if ((cc) == 0 && sl < 0) xd[i] = 0u; else xd[i] = *(const unsigned*)(XR + ((size_t)((b * 32 + (tk >> 7)) * 32 + h) * 128 + (tk & 127)) * 64 + cp2); } \
            psc0 = *(const f32x4*)(sch + (cc) * 128 + rb8); psc1 = *(const f32x4*)(sch + (cc) * 128 + rb8 + 4); \
            if (tid < 128) { pac = ach[(cc) * 128 + tid]; pdt = dth[(cc) * 128 + tid]; pdw = dwh[(cc) * 128 + tid]; } } while (0)
        SSD_LOAD(0);
        for (int c = 0; c < 32; ++c) {
            const int t0 = b * SEQ + c * 128;
            LAS float* sAc = (LAS float*)(lds + L_AC); LAS float* sDt = sAc + 128; LAS float* sDw = (LAS float*)(lds + L_XW + 64 * SROW);
            __syncthreads();
#pragma unroll
            for (int i = 0; i < 4; ++i) { const int piece = tid + 512 * i, row = piece >> 4, c16 = piece & 15;
                *(LAS u32x4*)(lds + L_B + row * SROW + c16 * 16) = rb[i];
                *(LAS u32x4*)(lds + L_C + row * SROW + c16 * 16) = rc[i];
            }
            if (tid < 128) { sAc[tid] = pac; sDt[tid] = pdt; sDw[tid] = pdw; }
            { float xa[8], xb[8]; bf16x2_t pa[10], pb2[10];
#pragma unroll
                for (int i = 0; i < 10; ++i) { pa[i] = __builtin_bit_cast(bf16x2_t, __builtin_amdgcn_perm(xd[i + 1], xd[i], 0x05040100u));
                    pb2[i] = __builtin_bit_cast(bf16x2_t, __builtin_amdgcn_perm(xd[i + 1], xd[i], 0x07060302u)); }
#pragma unroll
                for (int k = 0; k < 8; ++k) { xa[k] = silu_f(__builtin_amdgcn_fdot2_f32_bf16(w23a, pa[k + 2], __builtin_amdgcn_fdot2_f32_bf16(w01a, pa[k], cbxa, false), false));
                    xb[k] = silu_f(__builtin_amdgcn_fdot2_f32_bf16(w23b, pb2[k + 2], __builtin_amdgcn_fdot2_f32_bf16(w01b, pb2[k], cbxb, false), false)); }
                *(LAS u32x4*)(lds + L_XT + cp2 * SROW + rb8 * 2) = pack8(xa);
                *(LAS u32x4*)(lds + L_XT + (cp2 + 1) * SROW + rb8 * 2) = pack8(xb);
#pragma unroll
                for (int k = 0; k < 8; ++k) { const float sc = k < 4 ? psc0[k & 3] : psc1[k & 3]; xa[k] *= sc; xb[k] *= sc; }
                *(LAS u32x4*)(lds + L_XW + cp2 * SROW + rb8 * 2) = pack8(xa);
                *(LAS u32x4*)(lds + L_XW + (cp2 + 1) * SROW + rb8 * 2) = pack8(xb); }
            if (c < 31) SSD_LOAD(c + 1);
            __syncthreads();
            const int lr = lane >> 2, pc = (lane & 3) * 16; const int tz = t0 + 16 * lt + lr;
            bf16_t* zp = Z + ((size_t)((b * 32 + c) * 32 + h) * 128 + (16 * lt + lr)) * 64 + pc;
            const u32x4 z0 = *(const u32x4*)zp, z1 = *(const u32x4*)(zp + 8);
            const float aend = sAc[127];
            const float al = sAc[16 * lt + r16];
            bf16x8 cf[4];
#pragma unroll
            for (int ks = 0; ks < 4; ++ks) cf[ks] = *(const LAS bf16x8*)(lds + L_C + (16 * lt + r16) * SROW + (32 * ks + 8 * q) * 2);
            f32x4 yT[4];
#pragma unroll
            for (int pt = 0; pt < 4; ++pt) { yT[pt] = (f32x4){0.f, 0.f, 0.f, 0.f};
#pragma unroll
                for (int ks = 0; ks < 4; ++ks) { const bf16x8 a = *(const LAS bf16x8*)(lds + L_ST + (c & 1) * (64 * SROW) + (16 * pt + r16) * SROW + (32 * ks + 8 * q) * 2);
                    yT[pt] = __builtin_amdgcn_mfma_f32_16x16x32_bf16(a, cf[ks], yT[pt], 0, 0, 0); } }
            { const float el = __expf(al);
#pragma unroll
                for (int pt = 0; pt < 4; ++pt) yT[pt] *= el; }
            { const float ee = __expf(aend);
#pragma unroll
                for (int pt = 0; pt < 4; ++pt) stT[pt] *= ee;
#pragma unroll
                for (int ks = 0; ks < 4; ++ks) {
                    const LAS unsigned char* tb = lds + L_B + (32 * ks + 8 * q + ((lane & 15) >> 2)) * SROW + w * 32 + (lane & 3) * 8;
                    const s16x4 t0v = __builtin_amdgcn_ds_read_tr16_b64_v4i16((LAS s16x4*)tb), t1v = __builtin_amdgcn_ds_read_tr16_b64_v4i16((LAS s16x4*)(tb + 4 * SROW));
                    bf16x8 a; a[0] = t0v[0]; a[1] = t0v[1]; a[2] = t0v[2]; a[3] = t0v[3]; a[4] = t1v[0]; a[5] = t1v[1]; a[6] = t1v[2]; a[7] = t1v[3];
#pragma unroll
                    for (int pt = 0; pt < 4; ++pt) { const bf16x8 bx = *(const LAS bf16x8*)(lds + L_XW + (16 * pt + r16) * SROW + (32 * ks + 8 * q) * 2);
                        stT[pt] = __builtin_amdgcn_mfma_f32_16x16x32_bf16(a, bx, stT[pt], 0, 0, 0); } }
#pragma unroll
                for (int pt = 0; pt < 4; ++pt) { u32x2 o; o[0] = cvt_pk_bf16(stT[pt][0], stT[pt][1]); o[1] = cvt_pk_bf16(stT[pt][2], stT[pt][3]);
                    *(LAS u32x2*)(lds + L_ST + ((c + 1) & 1) * (64 * SROW) + (16 * pt + r16) * SROW + (16 * w + 4 * q) * 2) = o; } }
            const int lrow = 16 * lt + r16;
            for (int sp = 0; sp <= (lt >> 1); ++sp) {
                unsigned mfr[4];
#pragma unroll
                for (int hf = 0; hf < 2; ++hf) { const int sb = 32 * sp + 16 * hf; f32x4 cb4 = (f32x4){0.f, 0.f, 0.f, 0.f};
                    if (sb <= 16 * lt + 15) {
#pragma unroll
                        for (int ks = 0; ks < 4; ++ks) { const bf16x8 a = *(const LAS bf16x8*)(lds + L_B + (sb + r16) * SROW + (32 * ks + 8 * q) * 2);
                            cb4 = __builtin_amdgcn_mfma_f32_16x16x32_bf16(a, cf[ks], cb4, 0, 0, 0); }
                        const f32x4 as4 = *(const LAS f32x4*)(sAc + sb + 4 * q), dt4 = *(const LAS f32x4*)(sDt + sb + 4 * q);
                        if (sb < 16 * lt) {
                            const f32x4 dw4 = *(const LAS f32x4*)(sDw + sb + 4 * q); const float et = __expf(al - sAc[sb + 15]);
#pragma unroll
                            for (int r = 0; r < 4; ++r) cb4[r] = cb4[r] * (et * dw4[r]);
                        } else {
#pragma unroll
                            for (int r = 0; r < 4; ++r) { const int s_ = sb + 4 * q + r; cb4[r] = (s_ <= lrow) ? cb4[r] * __expf(al - as4[r]) * dt4[r] : 0.f; if (s_ == lrow) cb4[r] += Dh; }
                        }
                    }
                    mfr[2 * hf] = cvt_pk_bf16(cb4[0], cb4[1]); mfr[2 * hf + 1] = cvt_pk_bf16(cb4[2], cb4[3]); }
                bf16x8 mf; { u32x4 t; t[0] = mfr[0]; t[1] = mfr[1]; t[2] = mfr[2]; t[3] = mfr[3]; mf = __builtin_bit_cast(bf16x8, t); }
#pragma unroll
                for (int pt = 0; pt < 4; ++pt) { const u32x2 x0 = *(const LAS u32x2*)(lds + L_XT + (16 * pt + r16) * SROW + (32 * sp + 4 * q) * 2);
                    const u32x2 x1 = *(const LAS u32x2*)(lds + L_XT + (16 * pt + r16) * SROW + (32 * sp + 16 + 4 * q) * 2);
                    u32x4 t; t[0] = x0[0]; t[1] = x0[1]; t[2] = x1[0]; t[3] = x1[1];
                    yT[pt] = __builtin_amdgcn_mfma_f32_16x16x32_bf16(__builtin_bit_cast(bf16x8, t), mf, yT[pt], 0, 0, 0); }
            }
#pragma unroll
            for (int pt = 0; pt < 4; ++pt) { f32x4 o;
#pragma unroll
                for (int r = 0; r < 4; ++r) o[r] = yT[pt][r];
                *(LAS f32x4*)(lds + L_C + lrow * SROW + (16 * pt + 4 * q) * 4) = o; }
            asm volatile("s_waitcnt lgkmcnt(0)" ::: "memory");
            { float yv[16];
#pragma unroll
                for (int i = 0; i < 4; ++i) { const f32x4 v = *(const LAS f32x4*)(lds + L_C + (16 * lt + lr) * SROW + (pc + 4 * i) * 4); yv[4 * i] = v[0]; yv[4 * i + 1] = v[1]; yv[4 * i + 2] = v[2]; yv[4 * i + 3] = v[3]; }
                float ss = 0.f;
#pragma unroll
                for (int i = 0; i < 8; ++i) { const unsigned zw = i < 4 ? z0[i] : z1[i - 4];
                    yv[2 * i] *= bf_lo(zw); yv[2 * i + 1] *= bf_hi(zw); ss += yv[2 * i] * yv[2 * i] + yv[2 * i + 1] * yv[2 * i + 1]; }
                bf16_t* yp = zp;
                *(u32x4*)yp = pack8(yv); *(u32x4*)(yp + 8) = pack8(yv + 8);
                ss += __shfl_xor(ss, 1); ss += __shfl_xor(ss, 2);
                if ((lane & 3) == 0) HSQ[(size_t)tz * 32 + h] = ss; }
        }
#undef SSD_LOAD
    }
    __syncthreads();
}

constexpr int AK_ROW = 144, L_AK = 0, L_AV = 448 * AK_ROW, ATT_LDS_END = L_AV + 448 * AK_ROW;
static_assert(ATT_LDS_END <= LDS_BYTES - 16, "attention LDS");
__device__ __forceinline__ void phase_attn(const Params& P, LAS unsigned char* lds, bf16_t* ogdst) {
    unsigned char* ws = P.ws;
    const bf16_t* Kb = (const bf16_t*)(ws + WS_RZ); const bf16_t* VT = (const bf16_t*)(ws + WS_RZ + 64 * MiB); const bf16_t* Qb = (const bf16_t*)(ws + WS_RZ + 128 * MiB);
    const bf16_t* Gb = (const bf16_t*)(ws + WS_RZ + 192 * MiB);
    const int tid = threadIdx.x, w = __builtin_amdgcn_readfirstlane(tid >> 6), lane = tid & 63, h2 = lane >> 5, r32 = lane & 31;
    bf16x8 U[2];
#pragma unroll
    for (int s = 0; s < 2; ++s)
#pragma unroll
        for (int j = 0; j < 8; ++j) { const int key = 16 * s + 8 * (j >> 2) + 4 * h2 + (j & 3); U[s][j] = (key > r32) ? (short)0x3F80 : (short)0; }
    u32x4 tk[7], tv[7];
#define ATT_WIN_LOAD(it_) do { const int _qt0 = (15 - ((it_) >> 7)) * 8, _bh = (it_) & 127; const int _wlo = _qt0 > 6 ? _qt0 - 6 : 0; const int _nk = (_qt0 + 8 - _wlo) * 32; \
        const bf16_t* _Kp = Kb + (size_t)_bh * SEQ * 64 + (size_t)(_wlo * 32) * 64; const bf16_t* _Vp = VT + (size_t)_bh * SEQ * 64 + (size_t)(_wlo * 32) * 64; \
        _Pragma("unroll") for (int i = 0; i < 7; ++i) { const int pc = tid + 512 * i; if (pc < _nk * 8) { tk[i] = *(const u32x4*)(_Kp + (size_t)pc * 8); tv[i] = *(const u32x4*)(_Vp + (size_t)pc * 8); } } } while (0)
    if ((int)blockIdx.x < 128 * 16) ATT_WIN_LOAD((int)blockIdx.x);
    for (int item = blockIdx.x; item < 128 * 16; item += gridDim.x) {
        const int qb = 15 - (item >> 7), bh = item & 127; const int qt0 = qb * 8; const int wlo = qt0 > 6 ? qt0 - 6 : 0; const int nk = (qt0 + 8 - wlo) * 32;
        const bf16_t* Kp = Kb + (size_t)bh * SEQ * 64; const bf16_t* Vp = VT + (size_t)bh * SEQ * 64; const bf16_t* Qp = Qb + (size_t)bh * SEQ * 64;
        const int qt = qt0 + w, q0 = qt * 32;
        bf16x8 qf[4];
#pragma unroll
        for (int ks = 0; ks < 4; ++ks) qf[ks] = *(const bf16x8*)(Qp + (size_t)(q0 + r32) * 64 + 16 * ks + 8 * h2);
        __syncthreads();
        {
#pragma unroll
            for (int i = 0; i < 7; ++i) { const int pc = tid + 512 * i;
                if (pc < nk * 8) { *(LAS u32x4*)(lds + L_AK + (pc >> 3) * AK_ROW + (pc & 7) * 16) = tk[i];
                    *(LAS u32x4*)(lds + L_AV + (pc >> 3) * AK_ROW + (pc & 7) * 16) = tv[i]; } } }
        __syncthreads();
        asm volatile("s_waitcnt vmcnt(0)" ::: "memory");
        if (item + (int)gridDim.x < 128 * 16) ATT_WIN_LOAD(item + (int)gridDim.x);
        f32x16 o0, o1;
#pragma unroll
        for (int i = 0; i < 16; ++i) { o0[i] = 0.f; o1[i] = 0.f; }
        float carry = 0.f;
        for (int kt = qt; kt >= 0; --kt) {
            const int k0 = kt * 32; const bool diag = (kt == qt);
            bf16x8 kf[4], vf[2][2];
            if (kt >= wlo) { const int kl = (kt - wlo) * 32;
#pragma unroll
                for (int ks = 0; ks < 4; ++ks) kf[ks] = *(const LAS bf16x8*)(lds + L_AK + (kl + r32) * AK_ROW + (16 * ks + 8 * h2) * 2);
#pragma unroll
                for (int dt = 0; dt < 2; ++dt)
#pragma unroll
                    for (int s = 0; s < 2; ++s) {
                        const LAS unsigned char* vp = lds + L_AV + (kl + 16 * s + 4 * h2 + ((lane & 15) >> 2)) * AK_ROW + dt * 64 + ((lane >> 4) & 1) * 32 + (lane & 3) * 8;
                        const s16x4 t0v = __builtin_amdgcn_ds_read_tr16_b64_v4i16((LAS s16x4*)vp), t1v = __builtin_amdgcn_ds_read_tr16_b64_v4i16((LAS s16x4*)(vp + 8 * AK_ROW));
                        bf16x8 f; f[0] = t0v[0]; f[1] = t0v[1]; f[2] = t0v[2]; f[3] = t0v[3]; f[4] = t1v[0]; f[5] = t1v[1]; f[6] = t1v[2]; f[7] = t1v[3];
                        vf[dt][s] = f; }
            } else {
#pragma unroll
                for (int ks = 0; ks < 4; ++ks) kf[ks] = *(const bf16x8*)(Kp + (size_t)(k0 + r32) * 64 + 16 * ks + 8 * h2);
#pragma unroll
                for (int dt = 0; dt < 2; ++dt)
#pragma unroll
                    for (int s = 0; s < 2; ++s) { bf16x8 f;
#pragma unroll
                        for (int j = 0; j < 8; ++j) f[j] = (short)Vp[(size_t)(k0 + 16 * s + 8 * (j >> 2) + 4 * h2 + (j & 3)) * 64 + 32 * dt + r32];
                        vf[dt][s] = f; }
            }
            f32x16 S;
#pragma unroll
            for (int i = 0; i < 16; ++i) S[i] = 0.f;
#pragma unroll
            for (int ks = 0; ks < 4; ++ks) S = __builtin_amdgcn_mfma_f32_32x32x16_bf16(kf[ks], qf[ks], S, 0, 0, 0);
            float lk[16];
#pragma unroll
            for (int r = 0; r < 16; ++r) { const float z = S[r]; const float e = __builtin_amdgcn_exp2f(-fabsf(z));
                float v = -(__builtin_amdgcn_fmed3f(z, 0.f, 3.0e38f) + __builtin_amdgcn_logf(1.0f + e));
                if (diag) { const int key = (r & 3) + 8 * (r >> 2) + 4 * h2; v = (key < r32) ? v : 0.f; }
                lk[r] = v; }
            bf16x8 lf[2];
#pragma unroll
            for (int s = 0; s < 2; ++s) { u32x4 t;
#pragma unroll
                for (int i = 0; i < 4; ++i) t[i] = cvt_pk_bf16(lk[8 * s + 2 * i], lk[8 * s + 2 * i + 1]);
                lf[s] = __builtin_bit_cast(bf16x8, t); }
            f32x16 Suf;
#pragma unroll
            for (int i = 0; i < 16; ++i) Suf[i] = 0.f;
            Suf = __builtin_amdgcn_mfma_f32_32x32x16_bf16(U[0], lf[0], Suf, 0, 0, 0);
            Suf = __builtin_amdgcn_mfma_f32_32x32x16_bf16(U[1], lf[1], Suf, 0, 0, 0);
            const float tot = __shfl(Suf[0] + __uint_as_float(cvt_pk_bf16(lk[0], 0.f) << 16), r32);
            float pw[16];
#pragma unroll
            for (int r = 0; r < 16; ++r) { float wv = __builtin_amdgcn_exp2f(S[r] + lk[r] + Suf[r] + carry);
                if (diag) { const int key = (r & 3) + 8 * (r >> 2) + 4 * h2; wv = (key < r32) ? wv : 0.f; }
                pw[r] = wv; }
            bf16x8 pf[2];
#pragma unroll
            for (int s = 0; s < 2; ++s) { u32x4 t;
#pragma unroll
                for (int i = 0; i < 4; ++i) t[i] = cvt_pk_bf16(pw[8 * s + 2 * i], pw[8 * s + 2 * i + 1]);
                pf[s] = __builtin_bit_cast(bf16x8, t); }
            o0 = __builtin_amdgcn_mfma_f32_32x32x16_bf16(vf[0][0], pf[0], o0, 0, 0, 0);
            o0 = __builtin_amdgcn_mfma_f32_32x32x16_bf16(vf[0][1], pf[1], o0, 0, 0, 0);
            o1 = __builtin_amdgcn_mfma_f32_32x32x16_bf16(vf[1][0], pf[0], o1, 0, 0, 0);
            o1 = __builtin_amdgcn_mfma_f32_32x32x16_bf16(vf[1][1], pf[1], o1, 0, 0, 0);
            carry += tot;
            if (__all(carry < -160.0f)) break;
        }
        const int b = bh >> 4, head = bh & 15; const bf16_t* gp = Gb + (size_t)(b * SEQ + q0 + r32) * DM + head * 64; bf16_t* ogp = ogdst + (size_t)(b * SEQ + q0 + r32) * DM + head * 64;
#pragma unroll
        for (int dt = 0; dt < 2; ++dt)
#pragma unroll
            for (int gq = 0; gq < 4; ++gq) { const int d0 = 32 * dt + 8 * gq + 4 * h2; const u32x2 gv = *(const u32x2*)(gp + d0); u32x2 ov;
                const float a0 = dt ? o1[4 * gq] : o0[4 * gq], a1 = dt ? o1[4 * gq + 1] : o0[4 * gq + 1], a2 = dt ? o1[4 * gq + 2] : o0[4 * gq + 2], a3 = dt ? o1[4 * gq + 3] : o0[4 * gq + 3];
                ov[0] = cvt_pk_bf16(a0 * bf_lo(gv[0]), a1 * bf_hi(gv[0])); ov[1] = cvt_pk_bf16(a2 * bf_lo(gv[1]), a3 * bf_hi(gv[1]));
                *(u32x2*)(ogp + d0) = ov; }
    }
    __syncthreads();
}

#define XB_TMO      128
#define XB_XCNT(j)  (256  + 64 * (j))
#define XB_XSUB(j)  (1280 + 64 * (j))
#define XB_XGEN(j)  (2304 + 64 * (j))
#define XB_TOP      3328
#define XB_TOPGEN   3392
#define XCD_BAR_WORDS 3456
#define XB_SPIN_CAP (1u << 22)
__device__ __forceinline__ unsigned xb_ld(unsigned* p)              { return __hip_atomic_load(p, __ATOMIC_RELAXED, __HIP_MEMORY_SCOPE_AGENT); }
__device__ __forceinline__ unsigned xb_add(unsigned* p, unsigned v) { return __hip_atomic_fetch_add(p, v, __ATOMIC_RELAXED, __HIP_MEMORY_SCOPE_AGENT); }
__device__ __forceinline__ unsigned xb_xcc_id() { return (unsigned)__builtin_amdgcn_s_getreg((3 << 11) | 20) & 0xFu; }
#define XB_SPIN(cond, bar) do { unsigned _sp = 0; while (cond) { __builtin_amdgcn_s_sleep(1); \
    if ((++_sp & 255u) == 0u) { if (xb_ld(&(bar)[XB_TMO])) break; if (_sp > XB_SPIN_CAP) { atomicAdd(&(bar)[XB_TMO], 1u); break; } } } } while (0)
struct XcdBarrier { unsigned* bar; unsigned x; volatile LAS unsigned* st; };
__device__ __forceinline__ XcdBarrier xcd_barrier_post(unsigned* bar, volatile LAS unsigned* st) {
    XcdBarrier b; b.bar = bar; b.x = xb_xcc_id(); b.st = st;
    if (threadIdx.x == 0) (void)xb_add(&bar[XB_XCNT(b.x)], 1u);
    return b;
}
__device__ __forceinline__ void xcd_barrier_complete(unsigned* bar, unsigned x, unsigned& nloc, unsigned& nx) {
    const unsigned G = gridDim.x * gridDim.y * gridDim.z;
    unsigned sum, cnt, mine, sp = 0u;
    for (;;) {
        sum = 0u; cnt = 0u; mine = 0u;
#pragma unroll
        for (unsigned j = 0; j < 16; ++j) { const unsigned c = xb_ld(&bar[XB_XCNT(j)]); sum += c; cnt += (c > 0u) ? 1u : 0u; mine = (j == x) ? c : mine; }
        if (sum == G) break;
        __builtin_amdgcn_s_sleep(1);
        if ((++sp & 255u) == 0u) { if (xb_ld(&bar[XB_TMO])) break; if (sp > XB_SPIN_CAP) { atomicAdd(&bar[XB_TMO], 1u); break; } }
    }
    nloc = mine > 0u ? mine : 1u; nx = cnt > 0u ? cnt : 1u;
}
__device__ __forceinline__ void xcd_barrier(const XcdBarrier& b) {
    asm volatile("s_waitcnt vmcnt(0)" ::: "memory");
    __syncthreads();
    if (threadIdx.x == 0) {
        unsigned* bar = b.bar;
        __builtin_amdgcn_s_waitcnt(0);
        unsigned nloc = b.st[0], nx = b.st[1];
        if (nloc == 0u) { xcd_barrier_complete(bar, b.x, nloc, nx); b.st[0] = nloc; b.st[1] = nx; }
        const unsigned old = xb_add(&bar[XB_XSUB(b.x)], 1u);
        const unsigned gen = old / nloc;
        if (old + 1u == (gen + 1u) * nloc) {
            __builtin_amdgcn_fence(__ATOMIC_RELEASE, "agent");
            asm volatile("s_waitcnt vmcnt(0)" ::: "memory");
            const unsigned og = xb_add(&bar[XB_TOP], 1u);
            const unsigned tg = og / nx;
            if (og + 1u == (tg + 1u) * nx) xb_add(&bar[XB_TOPGEN], 1u);
            else XB_SPIN(xb_ld(&bar[XB_TOPGEN]) == tg, bar);
            __builtin_amdgcn_fence(__ATOMIC_ACQUIRE, "agent");
            xb_add(&bar[XB_XGEN(b.x)], 1u);
            asm volatile("s_waitcnt vmcnt(0)" ::: "memory");
        } else {
            XB_SPIN(xb_ld(&bar[XB_XGEN(b.x)]) == gen, bar);
            __builtin_amdgcn_fence(__ATOMIC_ACQUIRE, "agent");
            asm volatile("s_waitcnt vmcnt(0)" ::: "memory");
        }
    }
    __syncthreads();
}

constexpr int NPHASE = 11;
__global__ void __launch_bounds__(NTHREADS, 2) fwd_megakernel(Params P) {
    extern __shared__ __attribute__((aligned(16))) unsigned char lds_raw[];
    LAS unsigned char* lds = (LAS unsigned char*)lds_raw;
    cg::grid_group grid = cg::this_grid();
    if (P.ph_lo < 0) grid.sync();
    unsigned char* ws = P.ws;
    const int G = gridDim.x, c = blockIdx.x;
    bf16_t* Z = (bf16_t*)(ws + WS_RZ);
    float* ST = (float*)(ws + WS_ST); float* ST2 = (float*)(ws + WS_ST2);
    volatile LAS unsigned* xst = (volatile LAS unsigned*)(lds + LDS_BYTES - 16);
    if (threadIdx.x == 0) { xst[0] = 0u; xst[1] = 0u; }
    __syncthreads();
    XcdBarrier xbar = xcd_barrier_post((unsigned*)(ws + WS_BAR), xst);
#define IN(k) (P.ph_lo <= (k) && (k) < P.ph_hi)
#define SEAM(k) do { if (IN((k) + 1)) xcd_barrier(xbar); } while (0)
    if (IN(0)) {
        phase_prep(P);
        SEAM(0); }
    if (IN(1)) {
        phase_dt(P);
        pg8::Gemm g{(const bf16_t*)(ws + WS_RA), (const bf16_t*)(ws + WS_W1T), T_TOK, ZW, 1024, 1024}; pg8::StaticOrder S; S.init(T_TOK, ZW, G, c);
        EpiZ E{Z, (bf16_t*)(ws + WS_RZ + RZ_XR), (bf16_t*)(ws + WS_RZ + RZ_BCR)};
        pg8::gemm_phase(lds, g, S, E); SEAM(1); }
    if (IN(2)) {
        phase_conv(P);
        SEAM(2); }
    if (IN(3)) {
        phase_ssd(P, lds, Z, ZW);
        SEAM(3); }
    if (IN(5)) {
        pg8::Gemm g{Z, (const bf16_t*)(ws + WS_W2T), T_TOK, 1024, 2048, 64}; pg8::StaticOrder S; S.init(T_TOK, 1024, G, c);
        EpiH<true, false, false, true> E{(const float*)(ws + WS_HSQ), (LAS float*)(lds + pg8::STAGE_BYTES), P.x, nullptr, 0, nullptr, 0, nullptr, nullptr, (bf16_t*)(ws + WS_RZ + RZ_XR), 1024, ST};
        pg8::gemm_phase<EpiH<true, false, false, true>, true>(lds, g, S, E);
        SEAM(5); }
    if (IN(6)) {
        { pg8::Gemm g{(const bf16_t*)(ws + WS_RA), (const bf16_t*)(ws + WS_WP0), T_TOK, 1024, 256, 256}; pg8::StaticOrder S; S.init(T_TOK, 1024, G, c);
          EpiBf E{(bf16_t*)(ws + WS_RZ + 192 * MiB), 1024};
          pg8::gemm_phase(lds, g, S, E); }
        { pg8::Gemm g{(const bf16_t*)(ws + WS_RZ + RZ_XR), (const bf16_t*)(ws + WS_WG0), T_TOK, 1024, 1024, 1024}; pg8::StaticOrder S; S.init(T_TOK, 1024, G, c);
          EpiH<false, true, false> E{nullptr, nullptr, nullptr, (const bf16_t*)(ws + WS_RZ + RZ_XR), 1024, (const bf16_t*)(ws + WS_RZ + 192 * MiB), 1024, ST, nullptr, (bf16_t*)(ws + WS_RB), 1024, ST2};
          pg8::gemm_phase(lds, g, S, E); }
        SEAM(6); }
    if (IN(7)) {
        pg8::Gemm g{(const bf16_t*)(ws + WS_RB), (const bf16_t*)(ws + WS_WKVQG), T_TOK, 4096, 1024, 1024}; pg8::StaticOrder S; S.init(T_TOK, 4096, G, c);
        EpiKvqg E{ST2, Z, (bf16_t*)(ws + WS_RZ + 64 * MiB), (bf16_t*)(ws + WS_RZ + 128 * MiB), (bf16_t*)(ws + WS_RZ + 192 * MiB), P.k_norm, P.q_norm};
        pg8::gemm_phase(lds, g, S, E);
        SEAM(7); }
    if (IN(8)) {
        phase_attn(P, lds, (bf16_t*)(ws + WS_RZ + 192 * MiB));
        SEAM(8); }
    if (IN(9)) {
        pg8::Gemm g{(const bf16_t*)(ws + WS_RZ + 192 * MiB), (const bf16_t*)(ws + WS_WSO), T_TOK, 1024, 1024, 1024}; pg8::StaticOrder S; S.init(T_TOK, 1024, G, c);
        EpiH<false, false, false> E{nullptr, nullptr, nullptr, (const bf16_t*)(ws + WS_RB), 1024, nullptr, 0, nullptr, nullptr, (bf16_t*)(ws + WS_RZ + 256 * MiB), 1024, ST};
        pg8::gemm_phase(lds, g, S, E);
        SEAM(9); }
    if (IN(10)) {
        { pg8::Gemm g{(const bf16_t*)(ws + WS_RA + 16 * MiB), (const bf16_t*)(ws + WS_WP1), T_TOK, 1024, 256, 256}; pg8::StaticOrder S; S.init(T_TOK, 1024, G, c);
          EpiBf E{Z, 1024}; pg8::gemm_phase(lds, g, S, E); }
        { pg8::Gemm g{(const bf16_t*)(ws + WS_RZ + 256 * MiB), (const bf16_t*)(ws + WS_WG1), T_TOK, 1024, 1024, 1024}; pg8::StaticOrder S; S.init(T_TOK, 1024, G, c);
          EpiH<false, true, true> E{nullptr, nullptr, nullptr, (const bf16_t*)(ws + WS_RZ + 256 * MiB), 1024, Z, 1024, ST, P.out, nullptr, 0, nullptr};
          pg8::gemm_phase(lds, g, S, E); }
    }
#undef IN
#undef SEAM
}

extern "C" void kernel_launch(void* const* d_in, const int* in_sizes, int n_in, void* d_out, int out_size, void* d_ws, size_t ws_size, hipStream_t stream) {
    static int grid_blocks = 0;
    if (!grid_blocks) {
        int dev = 0, cus = 0, per_cu = 0;
        (void)hipGetDevice(&dev);
        (void)hipDeviceGetAttribute(&cus, hipDeviceAttributeMultiprocessorCount, dev);
        if (hipFuncSetAttribute((const void*)fwd_megakernel, hipFuncAttributeMaxDynamicSharedMemorySize, LDS_BYTES) != hipSuccess) fprintf(stderr, "hipFuncSetAttribute failed\n");
        if (hipOccupancyMaxActiveBlocksPerMultiprocessor(&per_cu, (const void*)fwd_megakernel, NTHREADS, LDS_BYTES) != hipSuccess || per_cu < 1) { fprintf(stderr, "occupancy query: %d\n", per_cu); per_cu = 1; }
        (void)hipGetLastError();
        grid_blocks = cus * per_cu;
        if (ws_size < WS_END) fprintf(stderr, "workspace too small: %zu < %zu\n", ws_size, (size_t)WS_END);
    }
    Params P{};
    P.x = (const float*)d_in[0]; P.p = (const float*)d_in[1]; P.m_norm = (const float*)d_in[2]; P.m_in = (const float*)d_in[3]; P.m_conv_w = (const float*)d_in[4];
    P.m_conv_b = (const float*)d_in[5]; P.m_dt_bias = (const float*)d_in[6]; P.m_A_log = (const float*)d_in[7]; P.m_D = (const float*)d_in[8]; P.m_ynorm = (const float*)d_in[9];
    P.m_out = (const float*)d_in[10]; P.kv_norm = (const float*)d_in[11]; P.w_kv = (const float*)d_in[12]; P.k_norm = (const float*)d_in[13]; P.s_norm = (const float*)d_in[14];
    P.s_in = (const float*)d_in[15]; P.q_norm = (const float*)d_in[16]; P.s_out = (const float*)d_in[17]; P.ple_norm = (const float*)d_in[18]; P.ple_gate = (const float*)d_in[19];
    P.ple_proj = (const float*)d_in[20];
    P.out = (float*)d_out; P.ws = (unsigned char*)d_ws; P.ph_lo = 0; P.ph_hi = NPHASE;
    (void)hipMemsetAsync((char*)d_ws + WS_BAR, 0, 16384, stream);
    void* args[] = {&P};
    hipError_t e = hipLaunchCooperativeKernel((const void*)fwd_megakernel, dim3(grid_blocks), dim3(NTHREADS), args, LDS_BYTES, stream);
    if (e != hipSuccess) fprintf(stderr, "cooperative launch failed: %s (grid %d)\n", hipGetErrorString(e), grid_blocks);
}
```
